# Optimizing an MI355X kernel written in HIP

```python
import jax
import jax.numpy as jnp
from jax import lax
import numpy as np

D_MODEL = 2048
BATCH = 2
SEQ = 4096
DEPTH = 4

N_MIXERS = 3
NSA_HEADS = 16
NSA_KV_GROUPS = 4
HEAD_DIM = D_MODEL // NSA_HEADS
HEADS_PER_GROUP = NSA_HEADS // NSA_KV_GROUPS
ROPE_DIM = HEAD_DIM // 4
ROPE_THETA = 500000.0
CMP_BLOCK = 32
CMP_STRIDE = 16
CMP_HIDDEN = 256
SEL_BLOCK = 64
SEL_TOP = 16
WINDOW = 512
ATTN_QBLOCK = 128
SEL_QCHUNK = 64
CONV_WIDTH = 3
SGU_WIDTH = D_MODEL
SGU_CHUNK = 128
SGU_GROUPS = 8
SGU_GROUP_DIM = SGU_WIDTH // SGU_GROUPS
D_FF = 5632
PLE_DIM = 256
N_NORMS = 8
EPS = 1e-6

kernel_name = "hybrid_nsa_conv_sgu_macaron_trunk"


def rms_norm(x, g):
    xf = x.astype(jnp.float32)
    y = xf * lax.rsqrt(jnp.mean(xf * xf, axis=-1, keepdims=True) + EPS) * g.astype(jnp.float32)
    return y.astype(x.dtype)


def layer_norm(x, g, b):
    xf = x.astype(jnp.float32)
    mu = jnp.mean(xf, axis=-1, keepdims=True)
    var = jnp.mean(jnp.square(xf - mu), axis=-1, keepdims=True)
    y = (xf - mu) * lax.rsqrt(var + EPS) * g.astype(jnp.float32) + b.astype(jnp.float32)
    return y.astype(x.dtype)


def swiglu(x, wg, wu, wd):
    return (jax.nn.silu(x @ wg) * (x @ wu)) @ wd


def masked_softmax(s, mask):
    s = jnp.where(mask, s, -jnp.inf)
    m = jnp.max(s, axis=-1, keepdims=True)
    m = jnp.where(jnp.isfinite(m), m, 0.0)
    e = jnp.where(mask, jnp.exp(s - m), 0.0)
    return e / jnp.maximum(jnp.sum(e, axis=-1, keepdims=True), 1e-30)


def partial_rotary(x, pos):
    half = ROPE_DIM // 2
    inv_freq = jnp.power(jnp.float32(ROPE_THETA), -jnp.arange(0, ROPE_DIM, 2, dtype=jnp.float32) / ROPE_DIM)
    ang = pos.astype(jnp.float32)[:, None] * inv_freq[None, :]
    cos = jnp.cos(ang)[None, :, None, :]
    sin = jnp.sin(ang)[None, :, None, :]
    xr = x[..., :ROPE_DIM].astype(jnp.float32)
    x1, x2 = xr[..., :half], xr[..., half:]
    rot = jnp.concatenate([x1 * cos - x2 * sin, x2 * cos + x1 * sin], axis=-1)
    return jnp.concatenate([rot.astype(x.dtype), x[..., ROPE_DIM:]], axis=-1)


def compress_blocks(kv, pe, w1, b1, w2):
    b_, s_, g_, dh = kv.shape
    n_sub = CMP_BLOCK // CMP_STRIDE
    nc = s_ // CMP_STRIDE - n_sub + 1
    ch = kv.reshape(b_, s_ // CMP_STRIDE, CMP_STRIDE, g_, dh)
    blocks = jnp.concatenate([ch[:, i:i + nc] for i in range(n_sub)], axis=2)
    blocks = blocks + pe[None, None, :, None, :]
    flat = jnp.moveaxis(blocks, 3, 2).reshape(b_, nc, g_, CMP_BLOCK * dh)
    return jax.nn.silu(flat @ w1 + b1) @ w2


def nsa_mixer(h, w_in, w_out, phi_pe, phi_w1, phi_b1, phi_w2):
    b_, s_, _ = h.shape
    H, G, R, Dh = NSA_HEADS, NSA_KV_GROUPS, HEADS_PER_GROUP, HEAD_DIM
    dt = h.dtype
    scale = HEAD_DIM ** -0.5
    sizes = [H * Dh] + [G * Dh] * 6 + [3 * H]
    offs = []
    acc = 0
    for sz in sizes[:-1]:
        acc += sz
        offs.append(acc)
    q, k_c, v_c, k_s, v_s, k_w, v_w, gates = jnp.split(h @ w_in, offs, axis=-1)
    q = q.reshape(b_, s_, G, R, Dh)
    k_c, v_c, k_s, v_s, k_w, v_w = [t.reshape(b_, s_, G, Dh) for t in (k_c, v_c, k_s, v_s, k_w, v_w)]
    pos = jnp.arange(s_)

    kc = compress_blocks(k_c, phi_pe[0], phi_w1[0], phi_b1[0], phi_w2[0])
    vc = compress_blocks(v_c, phi_pe[1], phi_w1[1], phi_b1[1], phi_w2[1])
    nc = kc.shape[1]
    sc = jnp.einsum('btgrd,bcgd->bgrtc', q, kc).astype(jnp.float32) * scale
    c_start = jnp.arange(nc) * CMP_STRIDE
    c_end = c_start + CMP_BLOCK - 1
    p_cmp = masked_softmax(sc, c_end[None, :] <= pos[:, None])
    o_cmp = jnp.einsum('bgrtc,bcgd->btgrd', p_cmp.astype(dt), vc)

    n_sel = s_ // SEL_BLOCK
    j_start = jnp.arange(n_sel) * SEL_BLOCK
    j_end = j_start + SEL_BLOCK - 1
    overlap = jnp.clip(jnp.minimum(c_end[:, None], j_end[None, :]) - jnp.maximum(c_start[:, None], j_start[None, :]) + 1, 0)
    overlap = overlap.astype(jnp.float32) / CMP_STRIDE
    imp = jnp.einsum('bgrtc,cj->bgtj', p_cmp, overlap)
    cur = pos // SEL_BLOCK
    blk = jnp.arange(n_sel)
    imp = jnp.where(blk[None, :] > cur[:, None], -jnp.inf, imp)
    forced = (blk[None, :] == 0) | (blk[None, :] == cur[:, None]) | (blk[None, :] == cur[:, None] - 1)
    imp = jnp.where(forced, jnp.inf, imp)
    n_top = min(SEL_TOP, n_sel)
    _, idx = lax.top_k(imp, n_top)

    q_r = partial_rotary(q.reshape(b_, s_, H, Dh), pos).reshape(b_, s_, G, R, Dh)
    k_s = partial_rotary(k_s, pos)
    k_w = partial_rotary(k_w, pos)

    ks_blk = jnp.transpose(k_s.reshape(b_, n_sel, SEL_BLOCK, G, Dh), (0, 3, 1, 2, 4))
    vs_blk = jnp.transpose(v_s.reshape(b_, n_sel, SEL_BLOCK, G, Dh), (0, 3, 1, 2, 4))
    nq = s_ // SEL_QCHUNK
    q_chunks = jnp.swapaxes(q_r.reshape(b_, nq, SEL_QCHUNK, G, R, Dh), 0, 1)
    idx_chunks = jnp.swapaxes(jnp.transpose(idx, (0, 2, 1, 3)).reshape(b_, nq, SEL_QCHUNK, G, n_top), 0, 1)
    pos_chunks = pos.reshape(nq, SEL_QCHUNK)
    bi = jnp.arange(b_)[:, None, None, None]
    gi = jnp.arange(G)[None, None, :, None]

    def sel_chunk(args):
        qc, ic, tc = args
        kg = ks_blk[bi, gi, ic]
        vg = vs_blk[bi, gi, ic]
        s = jnp.einsum('btgrd,btgnjd->btgrnj', qc, kg).astype(jnp.float32) * scale
        kpos = ic[..., None] * SEL_BLOCK + jnp.arange(SEL_BLOCK)
        m = (kpos <= tc[None, :, None, None, None]).reshape(b_, SEL_QCHUNK, G, 1, n_top * SEL_BLOCK)
        pr = masked_softmax(s.reshape(b_, SEL_QCHUNK, G, R, n_top * SEL_BLOCK), m)
        return jnp.einsum('btgrk,btgkd->btgrd', pr.astype(dt), vg.reshape(b_, SEL_QCHUNK, G, n_top * SEL_BLOCK, Dh))

    o_sel = lax.map(sel_chunk, (q_chunks, idx_chunks, pos_chunks))
    o_sel = jnp.swapaxes(o_sel, 0, 1).reshape(b_, s_, G, R, Dh)

    nb = s_ // ATTN_QBLOCK
    n_prev = WINDOW // ATTN_QBLOCK
    band = (n_prev + 1) * ATTN_QBLOCK
    pad = ((0, 0), (n_prev, 0), (0, 0), (0, 0), (0, 0))
    kw_p = jnp.pad(k_w.reshape(b_, nb, ATTN_QBLOCK, G, Dh), pad)
    vw_p = jnp.pad(v_w.reshape(b_, nb, ATTN_QBLOCK, G, Dh), pad)
    k_band = jnp.concatenate([kw_p[:, i:i + nb] for i in range(n_prev + 1)], axis=2)
    v_band = jnp.concatenate([vw_p[:, i:i + nb] for i in range(n_prev + 1)], axis=2)
    qw = q_r.reshape(b_, nb, ATTN_QBLOCK, G, R, Dh)
    sw = jnp.einsum('bntgrd,bnsgd->bngrts', qw, k_band).astype(jnp.float32) * scale
    tpos = jnp.arange(nb)[:, None] * ATTN_QBLOCK + jnp.arange(ATTN_QBLOCK)[None, :]
    spos = (jnp.arange(nb)[:, None] - n_prev) * ATTN_QBLOCK + jnp.arange(band)[None, :]
    diff = tpos[:, :, None] - spos[:, None, :]
    mw = (spos[:, None, :] >= 0) & (diff >= 0) & (diff < WINDOW)
    pw = masked_softmax(sw, mw[None, :, None, None])
    o_win = jnp.einsum('bngrts,bnsgd->bntgrd', pw.astype(dt), v_band).reshape(b_, s_, G, R, Dh)

    g = jax.nn.sigmoid(gates.astype(jnp.float32)).reshape(b_, s_, 3, G, R, 1)
    o = (g[:, :, 0] * o_cmp.astype(jnp.float32) + g[:, :, 1] * o_sel.astype(jnp.float32)
         + g[:, :, 2] * o_win.astype(jnp.float32)).astype(dt)
    return o.reshape(b_, s_, H * Dh) @ w_out


def conv_mixer(h, w_in, conv_w, w_out):
    b_gate, c_gate, u = jnp.split(h @ w_in, 3, axis=-1)
    z = c_gate * u
    z = lax.conv_general_dilated(z, conv_w[:, None, :], window_strides=(1,), padding=[(CONV_WIDTH - 1, 0)],
                                 dimension_numbers=('NWC', 'WIO', 'NWC'), feature_group_count=D_MODEL)
    return (b_gate * z) @ w_out


def sgu_mixer(h, w_in, ln_g, ln_b, w_s, b_s, w_out):
    b_, s_, _ = h.shape
    z = jax.nn.gelu(h @ w_in)
    u, v = jnp.split(z, 2, axis=-1)
    v = layer_norm(v, ln_g, ln_b)
    vc = v.reshape(b_, s_ // SGU_CHUNK, SGU_CHUNK, SGU_GROUPS, SGU_GROUP_DIM)
    causal = jnp.tril(jnp.ones((SGU_CHUNK, SGU_CHUNK), dtype=bool))
    ws = jnp.where(causal, w_s, 0)
    sv = jnp.einsum('gts,bcsgd->bctgd', ws, vc) + jnp.swapaxes(b_s, 0, 1)[None, None, :, :, None]
    return (u * sv.reshape(b_, s_, SGU_WIDTH)) @ w_out


def _normal(key, shape, scale):
    return jax.random.normal(key, shape, jnp.float32) * scale


def setup_inputs(seed: int = 0) -> dict:
    key = jax.random.key(seed)
    ks = jax.random.split(key, 26)
    D = D_MODEL
    n_a = len(range(0, DEPTH, N_MIXERS))
    n_b = len(range(1, DEPTH, N_MIXERS))
    n_c = len(range(2, DEPTH, N_MIXERS))
    nsa_in = NSA_HEADS * HEAD_DIM + 6 * NSA_KV_GROUPS * HEAD_DIM + 3 * NSA_HEADS
    return {
        "x": _normal(ks[0], (BATCH, SEQ, D), 1.0),
        "p": _normal(ks[1], (DEPTH, BATCH, SEQ, PLE_DIM), 1.0),
        "norm_g": 1.0 + _normal(ks[2], (DEPTH, N_NORMS, D), 0.02),
        "ffn1_wg": _normal(ks[3], (DEPTH, D, D_FF), D ** -0.5),
        "ffn1_wu": _normal(ks[4], (DEPTH, D, D_FF), D ** -0.5),
        "ffn1_wd": _normal(ks[5], (DEPTH, D_FF, D), D_FF ** -0.5),
        "ffn2_wg": _normal(ks[6], (DEPTH, D, D_FF), D ** -0.5),
        "ffn2_wu": _normal(ks[7], (DEPTH, D, D_FF), D ** -0.5),
        "ffn2_wd": _normal(ks[8], (DEPTH, D_FF, D), D_FF ** -0.5),
        "ple_wg": _normal(ks[9], (DEPTH, D, D), D ** -0.5),
        "ple_wp": _normal(ks[10], (DEPTH, PLE_DIM, D), PLE_DIM ** -0.5),
        "nsa_w_in": _normal(ks[11], (n_a, D, nsa_in), D ** -0.5),
        "nsa_w_out": _normal(ks[12], (n_a, NSA_HEADS * HEAD_DIM, D), (NSA_HEADS * HEAD_DIM) ** -0.5),
        "nsa_phi_pe": _normal(ks[13], (n_a, 2, CMP_BLOCK, HEAD_DIM), 0.02),
        "nsa_phi_w1": _normal(ks[14], (n_a, 2, CMP_BLOCK * HEAD_DIM, CMP_HIDDEN), (CMP_BLOCK * HEAD_DIM) ** -0.5),
        "nsa_phi_b1": _normal(ks[15], (n_a, 2, CMP_HIDDEN), 0.02),
        "nsa_phi_w2": _normal(ks[16], (n_a, 2, CMP_HIDDEN, HEAD_DIM), CMP_HIDDEN ** -0.5),
        "conv_w_in": _normal(ks[17], (n_b, D, 3 * D), D ** -0.5),
        "conv_w": _normal(ks[18], (n_b, CONV_WIDTH, D), CONV_WIDTH ** -0.5),
        "conv_w_out": _normal(ks[19], (n_b, D, D), D ** -0.5),
        "sgu_w_in": _normal(ks[20], (n_c, D, 2 * SGU_WIDTH), D ** -0.5),
        "sgu_ln_g": 1.0 + _normal(ks[21], (n_c, SGU_WIDTH), 0.02),
        "sgu_ln_b": _normal(ks[22], (n_c, SGU_WIDTH), 0.02),
        "sgu_w_s": _normal(ks[23], (n_c, SGU_GROUPS, SGU_CHUNK, SGU_CHUNK), SGU_CHUNK ** -0.5),
        "sgu_b_s": 1.0 + _normal(ks[24], (n_c, SGU_GROUPS, SGU_CHUNK), 0.02),
        "sgu_w_out": _normal(ks[25], (n_c, SGU_WIDTH, D), SGU_WIDTH ** -0.5),
    }


def reference(x, p, norm_g, ffn1_wg, ffn1_wu, ffn1_wd, ffn2_wg, ffn2_wu, ffn2_wd, ple_wg, ple_wp,
              nsa_w_in, nsa_w_out, nsa_phi_pe, nsa_phi_w1, nsa_phi_b1, nsa_phi_w2,
              conv_w_in, conv_w, conv_w_out,
              sgu_w_in, sgu_ln_g, sgu_ln_b, sgu_w_s, sgu_b_s, sgu_w_out):
    h = x
    for i in range(DEPTH):
        g = norm_g[i]
        j = i // N_MIXERS
        h = h + 0.5 * rms_norm(swiglu(rms_norm(h, g[0]), ffn1_wg[i], ffn1_wu[i], ffn1_wd[i]), g[1])
        hn = rms_norm(h, g[2])
        kind = i % N_MIXERS
        if kind == 0:
            m = nsa_mixer(hn, nsa_w_in[j], nsa_w_out[j], nsa_phi_pe[j], nsa_phi_w1[j], nsa_phi_b1[j], nsa_phi_w2[j])
        elif kind == 1:
            m = conv_mixer(hn, conv_w_in[j], conv_w[j], conv_w_out[j])
        else:
            m = sgu_mixer(hn, sgu_w_in[j], sgu_ln_g[j], sgu_ln_b[j], sgu_w_s[j], sgu_b_s[j], sgu_w_out[j])
        h = h + rms_norm(m, g[3])
        h = h + 0.5 * rms_norm(swiglu(rms_norm(h, g[4]), ffn2_wg[i], ffn2_wu[i], ffn2_wd[i]), g[5])
        gate = jax.nn.sigmoid(rms_norm(h, g[6]) @ ple_wg[i])
        h = h + rms_norm(gate * (p[i] @ ple_wp[i]), g[7])
    return h
```

```cpp
#include <hip/hip_runtime.h>
#include <cstdio>
#include <cstdint>
#include <type_traits>

#ifndef MK_ONE_LAUNCH
#define MK_ONE_LAUNCH 1
#endif
#ifndef FP8_GU_MASK
#define FP8_GU_MASK 0xFEu
#endif
#ifndef FP8_D_MASK
#define FP8_D_MASK 0xFEu
#endif
#define GU_F8(hs_) (((FP8_GU_MASK) >> (hs_)) & 1u)
#define D_F8(hs_)  (((FP8_D_MASK) >> (hs_)) & 1u)
constexpr bool ffn_combo_used(unsigned gu, unsigned d) { for (int hs = 0; hs < 8; ++hs) if (GU_F8(hs) == gu && D_F8(hs) == d) return true; return false; }
constexpr bool ffn_d_used(unsigned d) { for (int hs = 0; hs < 8; ++hs) if (D_F8(hs) == d) return true; return false; }
#ifndef MK_EN
#define MK_EN 0xFFFFFu
#endif
#define EN(b) ((MK_EN >> (b)) & 1u)

#define GAS __attribute__((address_space(1)))
#define LAS __attribute__((address_space(3)))
typedef unsigned short bf16_t;
typedef short bf16x8 __attribute__((ext_vector_type(8)));
typedef short s16x4 __attribute__((ext_vector_type(4)));
typedef float f32x4 __attribute__((ext_vector_type(4)));
typedef float f32x2 __attribute__((ext_vector_type(2)));
typedef unsigned u32x4 __attribute__((ext_vector_type(4)));
typedef unsigned u32x2 __attribute__((ext_vector_type(2)));

constexpr int D = 2048, BATCH = 2, SEQ = 4096, M = BATCH * SEQ, DEPTH = 4;
constexpr int FF = 5632, PLE = 256;
constexpr int NSA_N = 5168, NSA_NP = 5376;
constexpr int OFF_Q = 0, OFF_KC = 2048, OFF_VC = 2560, OFF_KS = 3072, OFF_VS = 3584, OFF_KW = 4096, OFF_VW = 4608, OFF_GATE = 5120;
constexpr float EPS = 1e-6f;

namespace pg8 {
#define PG8_LAS __attribute__((address_space(3)))
constexpr int BM = 256, BK = 64, HALF = 128, HTB = HALF * BK * 2, STAGE_BYTES = 8 * HTB, NXCD = 8, WGM = 8;
__host__ __device__ __forceinline__ int lds_byte(int r, int c) { const int st = (r >> 4) * 2 + (c >> 5), rr = r & 15, cc = c & 31, ob = rr * 64 + cc * 2; return st * 1024 + (ob ^ (((ob >> 9) & 1) << 5)); }
__host__ __device__ __forceinline__ void stage_rc(int b, int& R, int& C) { const int st = b / 1024, sb = b % 1024, swz = sb ^ (((sb >> 9) & 1) << 5); R = (st >> 1) * 16 + swz / 64; C = (st & 1) * 32 + (swz % 64) / 2; }
__host__ __device__ __forceinline__ int perm32(int rho) { const int n = rho >> 4, i = rho & 15; return 8 * (i >> 2) + 4 * n + (i & 3); }
constexpr int F8_SCALE_B = 0x79797979, F8_SCALE_A = 0x7C7C7C7C;
struct Unit { int pm, pn; };
struct Gemm { const bf16_t* A; const bf16_t* Bt; int M, N, K; };
struct StaticOrder {
    int nM, nN, nwg, G, c;
    __host__ __device__ void init(int M_, int N_, int G_, int c_) { nM = M_ / BM; nN = N_ / BM; nwg = nM * nN; G = G_; c = c_; }
    __host__ __device__ __forceinline__ bool next(int i, Unit& u) const {
        const long L = (long)i * G + c; if (L >= nwg) return false;
        int wgid = (int)L; { const int q = nwg / NXCD, r = nwg % NXCD, xcd = wgid % NXCD, off = wgid / NXCD; wgid = (xcd < r ? xcd * (q + 1) : r * (q + 1) + (xcd - r) * q) + off; }
        const int nig = WGM * nN, gid = wgid / nig, fm = gid * WGM, gsz = (nM - fm) < WGM ? (nM - fm) : WGM;
        u.pm = fm + ((wgid % nig) % gsz); u.pn = (wgid % nig) / gsz; return true;
    }
    __device__ __forceinline__ void a_ready(const Unit&) const {}
    __device__ __forceinline__ void done(const Unit&) const {}
};
typedef __bf16 bf16x2_hw __attribute__((ext_vector_type(2)));
__device__ __forceinline__ unsigned cvt_pk_bf16(float lo, float hi) { const f32x2 v = {lo, hi}; return __builtin_bit_cast(unsigned, __builtin_convertvector(v, bf16x2_hw)); }

typedef int v8i32 __attribute__((ext_vector_type(8)));
typedef int v4i32 __attribute__((ext_vector_type(4)));
template <class T, class = void> struct has_pre : std::false_type {};
template <class T> struct has_pre<T, std::void_t<decltype(T::HAS_PRE2)>> : std::true_type {};
template <class Epi, class Sched, bool ALIGN_EPI = false, bool SP2 = false, bool F8 = false>
__device__ __forceinline__ void gemm_phase(PG8_LAS unsigned char* lds, const Gemm g, const Sched& S, const Epi& E, int tid) {
    asm volatile("" : "+v"(tid));
    const int wid = __builtin_amdgcn_readfirstlane(tid >> 6), lane = tid & 63, wr = wid >> 2, wc = wid & 3, fr = lane & 15, fq = lane >> 4;
    const int K = g.K, nt = F8 ? K / 128 : K / BK; const int Kb = F8 ? K : 2 * K;
    unsigned voffA[2], voffB[2];
#pragma unroll
    for (int i = 0; i < 2; ++i) { int R, C; stage_rc(tid * 16 + i * 8192, R, C); const int Rb = Epi::PERM ? ((R & ~31) + perm32(R & 31)) : R;
        voffA[i] = (unsigned)(R * Kb + C * 2); voffB[i] = (unsigned)(Rb * Kb + C * 2); }
    const size_t kstep = (size_t)(BK * 2);
    const size_t hstep = (size_t)HALF * Kb;
    const size_t tstep = 2 * hstep;
    const unsigned ldsw = (unsigned)wid * 1024u;
    const int aoff = lds_byte(wr * 64 + fr, fq * 8), boff = lds_byte(wc * 32 + fr, fq * 8);
#define PG8_SA(b, h) (((b) * 2 + (h)) * HTB)
#define PG8_SB(b, h) ((4 + (b) * 2 + (h)) * HTB)
#define PG8_STAGE(bufoff, gbase, voff) do { _Pragma("unroll") for (int _i = 0; _i < 2; ++_i) \
        __builtin_amdgcn_global_load_lds((const unsigned*)((const char*)(gbase) + (voff)[_i]), (PG8_LAS unsigned*)(lds + (bufoff) + ldsw + _i * 8192), 16, 0, 0); } while (0)
#define PG8_LD16(off) __builtin_bit_cast(v4i32, *(const PG8_LAS bf16x8*)(lds + off))
#define PG8_LDA(dst, b, h) do { if constexpr (F8) { _Pragma("unroll") for (int m = 0; m < 4; ++m) dst##8[m] = __builtin_shufflevector(PG8_LD16(PG8_SA(b, h) + aoff + m * 2048 + 0 * 1024), PG8_LD16(PG8_SA(b, h) + aoff + m * 2048 + 1 * 1024), 0, 1, 2, 3, 4, 5, 6, 7); } \
        else { _Pragma("unroll") for (int m = 0; m < 4; ++m) _Pragma("unroll") for (int k = 0; k < 2; ++k) dst[m][k] = *(const PG8_LAS bf16x8*)(lds + PG8_SA(b, h) + aoff + m * 2048 + k * 1024); } } while (0)
#define PG8_LDB(dst, b, h) do { if constexpr (F8) { _Pragma("unroll") for (int n = 0; n < 2; ++n) dst##8[n] = __builtin_shufflevector(PG8_LD16(PG8_SB(b, h) + boff + n * 2048 + 0 * 1024), PG8_LD16(PG8_SB(b, h) + boff + n * 2048 + 1 * 1024), 0, 1, 2, 3, 4, 5, 6, 7); } \
        else { _Pragma("unroll") for (int n = 0; n < 2; ++n) _Pragma("unroll") for (int k = 0; k < 2; ++k) dst[n][k] = *(const PG8_LAS bf16x8*)(lds + PG8_SB(b, h) + boff + n * 2048 + k * 1024); } } while (0)
#define PG8_CAT8(x0, x1) __builtin_shufflevector(__builtin_bit_cast(v4i32, x0), __builtin_bit_cast(v4i32, x1), 0, 1, 2, 3, 4, 5, 6, 7)
#define PG8_MMA(ai, bj, At, Bt) do { __builtin_amdgcn_s_setprio(1); _Pragma("unroll") for (int m = 0; m < 4; ++m) _Pragma("unroll") for (int n = 0; n < 2; ++n) { \
        if constexpr (F8) asm volatile("v_mfma_scale_f32_16x16x128_f8f6f4 %0, %1, %2, %0, %3, %4 op_sel_hi:[0,0,0]" : "+v"(acc[ai][bj][m][n]) : "v"(Bt##8[n]), "v"(At##8[m]), "v"(f8sb), "v"(f8sa)); \
        else { _Pragma("unroll") for (int k = 0; k < 2; ++k) acc[ai][bj][m][n] = __builtin_amdgcn_mfma_f32_16x16x32_bf16(Bt[n][k], At[m][k], acc[ai][bj][m][n], 0, 0, 0); } } \
        __builtin_amdgcn_s_setprio(0); } while (0)
#define PG8_WAIT_V(n) asm volatile("s_waitcnt vmcnt(" #n ")" ::: "memory")
#define PG8_WAIT_L(n) asm volatile("s_waitcnt lgkmcnt(" #n ")" ::: "memory")
#define PG8_BAR __builtin_amdgcn_s_barrier()
#define PG8_SCHED __builtin_amdgcn_sched_barrier(0)
    Unit cur, nxt; int ui = 0;
    if (!S.next(0, cur)) return;
    f32x4 acc[2][2][4][2];
#pragma unroll
    for (int a = 0; a < 2; ++a)
#pragma unroll
        for (int b = 0; b < 2; ++b)
#pragma unroll
            for (int m = 0; m < 4; ++m)
#pragma unroll
                for (int n = 0; n < 2; ++n) acc[a][b][m][n] = (f32x4){0.f, 0.f, 0.f, 0.f};
    bf16x8 At[4][2], B0[2][2], B1[2][2];
    v8i32 At8[4], B08[2], B18[2];
    int f8sb = F8_SCALE_B, f8sa = F8_SCALE_A; asm volatile("" : "+v"(f8sb), "+v"(f8sa));
    const char* cA = (const char*)g.A + (size_t)cur.pm * tstep; const char* cB = (const char*)g.Bt + (size_t)cur.pn * tstep;
    S.a_ready(cur);
    if constexpr (SP2) {
        PG8_STAGE(PG8_SB(0, 0), cB, voffB); PG8_STAGE(PG8_SB(0, 1), cB + hstep, voffB); PG8_STAGE(PG8_SA(0, 0), cA, voffA); PG8_STAGE(PG8_SA(0, 1), cA + hstep, voffA);
        if constexpr (has_pre<Epi>::value) E.pre(tid);
        if (wr == 1) PG8_BAR;
        PG8_WAIT_V(2); PG8_BAR;
        PG8_STAGE(PG8_SB(1, 0), cB + kstep, voffB); PG8_STAGE(PG8_SA(1, 0), cA + kstep, voffA); PG8_STAGE(PG8_SB(1, 1), cB + hstep + kstep, voffB);
        PG8_WAIT_V(6); PG8_BAR;
    } else {
        PG8_STAGE(PG8_SB(0, 0), cB, voffB); PG8_STAGE(PG8_SA(0, 0), cA, voffA); PG8_STAGE(PG8_SB(0, 1), cB + hstep, voffB); PG8_STAGE(PG8_SA(0, 1), cA + hstep, voffA);
        if (wr == 1) PG8_BAR;
        PG8_WAIT_V(4); PG8_BAR;
        PG8_STAGE(PG8_SB(1, 0), cB + kstep, voffB); PG8_STAGE(PG8_SA(1, 0), cA + kstep, voffA); PG8_STAGE(PG8_SB(1, 1), cB + hstep + kstep, voffB);
        PG8_WAIT_V(6); PG8_BAR;
    }
    for (;;) {
        const bool has_next = S.next(ui + 1, nxt);
        const char* nA = has_next ? (const char*)g.A + (size_t)nxt.pm * tstep : cA; const char* nB = has_next ? (const char*)g.Bt + (size_t)nxt.pn * tstep : cB;
#pragma nounroll
        for (int t = 0; t < nt; t += 2) {
            const bool last = (t == nt - 2);
            const char* a1 = cA + (size_t)(t + 1) * kstep;
            const char* a2 = last ? nA : cA + (size_t)(t + 2) * kstep; const char* b2 = last ? nB : cB + (size_t)(t + 2) * kstep;
            const char* a3 = a2 + kstep; const char* b3 = b2 + kstep;
            if (last && has_next) S.a_ready(nxt);
            if constexpr (SP2) {
            PG8_LDB(B0, 0, 0); PG8_LDB(B1, 0, 1); PG8_SCHED; PG8_LDA(At, 0, 0); PG8_STAGE(PG8_SA(1, 1), a1 + hstep, voffA);
            PG8_WAIT_V(8); PG8_WAIT_L(0); PG8_BAR; PG8_MMA(0, 0, At, B0); PG8_MMA(0, 1, At, B1); PG8_BAR; PG8_SCHED;
            PG8_LDA(At, 0, 1); PG8_STAGE(PG8_SB(0, 0), b2, voffB); PG8_STAGE(PG8_SB(0, 1), b2 + hstep, voffB); PG8_STAGE(PG8_SA(0, 0), a2, voffA);
            PG8_WAIT_V(8); PG8_WAIT_L(0); PG8_BAR; PG8_MMA(1, 0, At, B0); PG8_MMA(1, 1, At, B1); PG8_BAR; PG8_SCHED;
            PG8_LDB(B0, 1, 0); PG8_LDB(B1, 1, 1); PG8_SCHED; PG8_LDA(At, 1, 0); PG8_STAGE(PG8_SA(0, 1), a2 + hstep, voffA);
            PG8_WAIT_V(8); PG8_WAIT_L(0); PG8_BAR; PG8_MMA(0, 0, At, B0); PG8_MMA(0, 1, At, B1); PG8_BAR; PG8_SCHED;
            PG8_LDA(At, 1, 1); PG8_STAGE(PG8_SB(1, 0), b3, voffB); PG8_STAGE(PG8_SB(1, 1), b3 + hstep, voffB); PG8_STAGE(PG8_SA(1, 0), a3, voffA);
            PG8_WAIT_V(8); PG8_WAIT_L(0); PG8_BAR; PG8_MMA(1, 0, At, B0); PG8_MMA(1, 1, At, B1); PG8_BAR; PG8_SCHED;
            } else {
            PG8_LDB(B0, 0, 0); PG8_SCHED; PG8_LDA(At, 0, 0); PG8_STAGE(PG8_SA(1, 1), a1 + hstep, voffA);
            PG8_WAIT_L(8); PG8_BAR; PG8_WAIT_L(0); PG8_MMA(0, 0, At, B0); PG8_BAR; PG8_SCHED;
            PG8_LDB(B1, 0, 1); PG8_STAGE(PG8_SB(0, 0), b2, voffB);
            PG8_BAR; PG8_WAIT_L(0); PG8_MMA(0, 1, At, B1); PG8_BAR;
            PG8_LDA(At, 0, 1); PG8_STAGE(PG8_SA(0, 0), a2, voffA);
            PG8_BAR; PG8_WAIT_L(0); PG8_MMA(1, 0, At, B0); PG8_BAR; PG8_SCHED;
            PG8_STAGE(PG8_SB(0, 1), b2 + hstep, voffB);
            PG8_WAIT_V(6); PG8_BAR; PG8_MMA(1, 1, At, B1); PG8_BAR;
            PG8_LDB(B0, 1, 0); PG8_SCHED; PG8_LDA(At, 1, 0); PG8_STAGE(PG8_SA(0, 1), a2 + hstep, voffA);
            PG8_WAIT_L(8); PG8_BAR; PG8_WAIT_L(0); PG8_MMA(0, 0, At, B0); PG8_BAR; PG8_SCHED;
            PG8_LDB(B1, 1, 1); PG8_STAGE(PG8_SB(1, 0), b3, voffB);
            PG8_BAR; PG8_WAIT_L(0); PG8_MMA(0, 1, At, B1); PG8_BAR;
            PG8_LDA(At, 1, 1); PG8_STAGE(PG8_SA(1, 0), a3, voffA);
            PG8_BAR; PG8_WAIT_L(0); PG8_MMA(1, 0, At, B0); PG8_BAR; PG8_SCHED;
            PG8_STAGE(PG8_SB(1, 1), b3 + hstep, voffB);
            PG8_WAIT_V(6); PG8_BAR; PG8_MMA(1, 1, At, B1); PG8_BAR;
            }
        }
        if constexpr (ALIGN_EPI) { if (wr == 0) PG8_BAR; }
        if constexpr (F8) asm volatile("s_nop 15\n\ts_nop 3" ::: "memory");
        E(acc, cur, wr, wc, fr, fq); S.done(cur);
        if (!has_next) break;
#pragma unroll
        for (int a = 0; a < 2; ++a)
#pragma unroll
            for (int b = 0; b < 2; ++b)
#pragma unroll
                for (int m = 0; m < 4; ++m)
#pragma unroll
                    for (int n = 0; n < 2; ++n) acc[a][b][m][n] = (f32x4){0.f, 0.f, 0.f, 0.f};
        cur = nxt; cA = nA; cB = nB; ++ui;
        if constexpr (ALIGN_EPI) { if (wr == 1) PG8_BAR; }
    }
    PG8_WAIT_V(0);
    if constexpr (!ALIGN_EPI) { if (wr == 0) PG8_BAR; }
    PG8_BAR;
#undef PG8_SA
#undef PG8_SB
#undef PG8_STAGE
#undef PG8_LDA
#undef PG8_LD16
#undef PG8_LDB
#undef PG8_MMA
#undef PG8_CAT8
#undef PG8_WAIT_V
#undef PG8_WAIT_L
#undef PG8_BAR
#undef PG8_SCHED
}

__device__ __forceinline__ float fast_sigmoid(float x) { return __builtin_amdgcn_rcpf(1.0f + __builtin_amdgcn_exp2f(-1.44269504f * x)); }
__device__ __forceinline__ float silu_f(float x) { return x * fast_sigmoid(x); }
__device__ __forceinline__ float gelu_tanh_f(float x) { const float y = 0.7978845608f * (x + 0.044715f * x * x * x); return x * fast_sigmoid(2.0f * y); }

__device__ __forceinline__ float row_rs(const float* ss, int row) {
    const f32x4 a = *(const f32x4*)(ss + (size_t)row * 8), b = *(const f32x4*)(ss + (size_t)row * 8 + 4);
    return __builtin_amdgcn_rsqf((((a[0] + a[1]) + (a[2] + a[3])) + ((b[0] + b[1]) + (b[2] + b[3]))) * (1.0f / 2048.0f) + 1e-6f);
}
__device__ __forceinline__ float rs_from(const f32x4 a, const f32x4 b) { return __builtin_amdgcn_rsqf((((a[0] + a[1]) + (a[2] + a[3])) + ((b[0] + b[1]) + (b[2] + b[3]))) * (1.0f / 2048.0f) + 1e-6f); }
struct EpiF32 {
    static constexpr bool PERM = false; static constexpr bool HAS_PRE = false;
    float* C; int ldc;
    __device__ __forceinline__ void operator()(const f32x4 (&acc)[2][2][4][2], const Unit& u, int wr, int wc, int fr, int fq) const {
        const int row0 = u.pm * BM + wr * 64 + fr, col0 = u.pn * BM + wc * 32 + 4 * fq;
#pragma unroll
        for (int ai = 0; ai < 2; ++ai)
#pragma unroll
            for (int m = 0; m < 4; ++m) { float* rowp = C + (size_t)(row0 + ai * HALF + m * 16) * ldc + col0;
#pragma unroll
                for (int bj = 0; bj < 2; ++bj)
#pragma unroll
                    for (int n = 0; n < 2; ++n) *(f32x4*)(rowp + bj * HALF + n * 16) = acc[ai][bj][m][n]; }
    }
};
struct EpiGateMul {
    static constexpr bool PERM = true; static constexpr bool HAS_PRE = false;
    bf16_t* C; const bf16_t* G; int ldc;
    __device__ __forceinline__ void operator()(const f32x4 (&acc)[2][2][4][2], const Unit& u, int wr, int wc, int fr, int fq) const {
        const int row0 = u.pm * BM + wr * 64 + fr, col0 = u.pn * BM + wc * 32 + 8 * fq;
#pragma unroll
        for (int ai = 0; ai < 2; ++ai)
#pragma unroll
            for (int m = 0; m < 4; ++m) { const size_t off = (size_t)(row0 + ai * HALF + m * 16) * ldc + col0;
#pragma unroll
                for (int bj = 0; bj < 2; ++bj) { const u32x4 gv = *(const u32x4*)(G + off + bj * HALF);
                    const f32x4 v0 = acc[ai][bj][m][0], v1 = acc[ai][bj][m][1];
                    u32x4 w; w.x = cvt_pk_bf16(v0[0] * __uint_as_float(gv.x << 16), v0[1] * __uint_as_float(gv.x & 0xffff0000u)); w.y = cvt_pk_bf16(v0[2] * __uint_as_float(gv.y << 16), v0[3] * __uint_as_float(gv.y & 0xffff0000u));
                    w.z = cvt_pk_bf16(v1[0] * __uint_as_float(gv.z << 16), v1[1] * __uint_as_float(gv.z & 0xffff0000u)); w.w = cvt_pk_bf16(v1[2] * __uint_as_float(gv.w << 16), v1[3] * __uint_as_float(gv.w & 0xffff0000u));
                    *(u32x4*)(C + off + bj * HALF) = w; asm volatile("" ::: "memory"); } }
    }
};
struct EpiSigMul {
    static constexpr bool PERM = true; static constexpr bool HAS_PRE = false;
    bf16_t* C; const bf16_t* P; int ldc; const float* rs;
    __device__ __forceinline__ void operator()(const f32x4 (&acc)[2][2][4][2], const Unit& u, int wr, int wc, int fr, int fq) const {
        const int row0 = u.pm * BM + wr * 64 + fr, col0 = u.pn * BM + wc * 32 + 8 * fq;
#pragma unroll
        for (int ai = 0; ai < 2; ++ai)
#pragma unroll
            for (int m = 0; m < 4; ++m) { const size_t off = (size_t)(row0 + ai * HALF + m * 16) * ldc + col0; const float rsv = row_rs(rs, row0 + ai * HALF + m * 16);
#pragma unroll
                for (int bj = 0; bj < 2; ++bj) { const u32x4 pv = *(const u32x4*)(P + off + bj * HALF);
                    const f32x4 v0 = acc[ai][bj][m][0] * rsv, v1 = acc[ai][bj][m][1] * rsv;
                    u32x4 w; w.x = cvt_pk_bf16(fast_sigmoid(v0[0]) * __uint_as_float(pv.x << 16), fast_sigmoid(v0[1]) * __uint_as_float(pv.x & 0xffff0000u));
                    w.y = cvt_pk_bf16(fast_sigmoid(v0[2]) * __uint_as_float(pv.y << 16), fast_sigmoid(v0[3]) * __uint_as_float(pv.y & 0xffff0000u));
                    w.z = cvt_pk_bf16(fast_sigmoid(v1[0]) * __uint_as_float(pv.z << 16), fast_sigmoid(v1[1]) * __uint_as_float(pv.z & 0xffff0000u));
                    w.w = cvt_pk_bf16(fast_sigmoid(v1[2]) * __uint_as_float(pv.w << 16), fast_sigmoid(v1[3]) * __uint_as_float(pv.w & 0xffff0000u));
                    *(u32x4*)(C + off + bj * HALF) = w; asm volatile("" ::: "memory"); } }
    }
};
template <int ACT> struct EpiBf16 {
    static constexpr bool PERM = true; static constexpr bool HAS_PRE = false;
    bf16_t* O; int ldc; const float* rs;
    PG8_LAS float* rsl = nullptr; int pm0 = -1;
    f32x4 ra = {0.f, 0.f, 0.f, 0.f}, rb = {0.f, 0.f, 0.f, 0.f};
    static constexpr bool HAS_PRE2 = true;
    __device__ __forceinline__ void pre(int tid) const { if (pm0 >= 0 && tid < 256) rsl[tid] = rs_from(ra, rb); }
    __device__ __forceinline__ void operator()(const f32x4 (&acc)[2][2][4][2], const Unit& u, int wr, int wc, int fr, int fq) const {
        const int row0 = u.pm * BM + wr * 64 + fr, col0 = u.pn * BM + wc * 32 + 8 * fq;
        const bool cached = (u.pm == pm0);
#pragma unroll
        for (int ai = 0; ai < 2; ++ai)
#pragma unroll
            for (int m = 0; m < 4; ++m) { bf16_t* rowp = O + (size_t)(row0 + ai * HALF + m * 16) * ldc + col0;
                const float rsv = rs ? (cached ? rsl[wr * 64 + fr + ai * HALF + m * 16] : row_rs(rs, row0 + ai * HALF + m * 16)) : 1.0f;
#pragma unroll
                for (int bj = 0; bj < 2; ++bj) { f32x4 v0 = acc[ai][bj][m][0] * rsv, v1 = acc[ai][bj][m][1] * rsv;
                    if (ACT == 1) {
#pragma unroll
                        for (int j = 0; j < 4; ++j) { v0[j] = gelu_tanh_f(v0[j]); v1[j] = gelu_tanh_f(v1[j]); } }
                    if (ACT == 2) {
#pragma unroll
                        for (int j = 0; j < 4; ++j) { v0[j] = fast_sigmoid(v0[j]); v1[j] = fast_sigmoid(v1[j]); } }
                    u32x4 w; w.x = cvt_pk_bf16(v0[0], v0[1]); w.y = cvt_pk_bf16(v0[2], v0[3]); w.z = cvt_pk_bf16(v1[0], v1[1]); w.w = cvt_pk_bf16(v1[2], v1[3]);
                    *(u32x4*)(rowp + bj * HALF) = w; } }
    }
};
template <bool F8OUT> struct EpiSwiglu {
    static constexpr bool PERM = true; static constexpr bool HAS_PRE = false;
    void* O; int ldc; const float* rs;
    PG8_LAS float* rsl; int pm0;
    f32x4 ra, rb;
    static constexpr bool HAS_PRE2 = true;
    __device__ __forceinline__ void pre(int tid) const { if (pm0 >= 0 && tid < 256) rsl[tid] = rs_from(ra, rb); }
    __device__ __forceinline__ void operator()(const f32x4 (&acc)[2][2][4][2], const Unit& u, int wr, int wc, int fr, int fq) const {
        const int row0 = u.pm * BM + wr * 64 + fr, col0 = u.pn * HALF + wc * 32 + 8 * fq;
        float rsr[2][4];
        if (u.pm == pm0) {
#pragma unroll
            for (int ai = 0; ai < 2; ++ai)
#pragma unroll
                for (int m = 0; m < 4; ++m) rsr[ai][m] = rsl[wr * 64 + fr + ai * HALF + m * 16];
        } else {
#pragma unroll
            for (int ai = 0; ai < 2; ++ai)
#pragma unroll
                for (int m = 0; m < 4; ++m) rsr[ai][m] = row_rs(rs, row0 + ai * HALF + m * 16);
        }
#pragma unroll
        for (int ai = 0; ai < 2; ++ai)
#pragma unroll
            for (int m = 0; m < 4; ++m) { const size_t eoff = (size_t)(row0 + ai * HALF + m * 16) * ldc + col0; const float rsv = rsr[ai][m];
                const float cexp = rsv * -1.44269504f, sc = rsv * rsv * (F8OUT ? 8.0f : 1.0f);
                f32x4 e0 = acc[ai][0][m][0] * cexp, e1 = acc[ai][0][m][1] * cexp, t0 = acc[ai][0][m][0] * acc[ai][1][m][0], t1 = acc[ai][0][m][1] * acc[ai][1][m][1];
                __builtin_amdgcn_sched_barrier(0);
#pragma unroll
                for (int j = 0; j < 4; ++j) { e0[j] = __builtin_amdgcn_exp2f(e0[j]); e1[j] = __builtin_amdgcn_exp2f(e1[j]); }
                __builtin_amdgcn_sched_barrier(0);
                e0 = e0 + 1.0f; e1 = e1 + 1.0f; t0 = t0 * sc; t1 = t1 * sc;
                __builtin_amdgcn_sched_barrier(0);
#pragma unroll
                for (int j = 0; j < 4; ++j) { e0[j] = __builtin_amdgcn_rcpf(e0[j]); e1[j] = __builtin_amdgcn_rcpf(e1[j]); }
                __builtin_amdgcn_sched_barrier(0);
                f32x4 v0 = t0 * e0, v1 = t1 * e1;
                if constexpr (F8OUT) {
                    int w0 = 0, w1 = 0;
#pragma unroll
                    for (int j = 0; j < 4; ++j) { v0[j] = __builtin_amdgcn_fmed3f(v0[j], -448.0f, 448.0f); v1[j] = __builtin_amdgcn_fmed3f(v1[j], -448.0f, 448.0f); }
                    w0 = __builtin_amdgcn_cvt_pk_fp8_f32(v0[0], v0[1], w0, false); w0 = __builtin_amdgcn_cvt_pk_fp8_f32(v0[2], v0[3], w0, true);
                    w1 = __builtin_amdgcn_cvt_pk_fp8_f32(v1[0], v1[1], w1, false); w1 = __builtin_amdgcn_cvt_pk_fp8_f32(v1[2], v1[3], w1, true);
                    u32x2 w; w.x = (unsigned)w0; w.y = (unsigned)w1; *(u32x2*)((unsigned char*)O + eoff) = w;
                } else {
                    u32x4 w; w.x = cvt_pk_bf16(v0[0], v0[1]); w.y = cvt_pk_bf16(v0[2], v0[3]); w.z = cvt_pk_bf16(v1[0], v1[1]); w.w = cvt_pk_bf16(v1[2], v1[3]);
                    *(u32x4*)((bf16_t*)O + eoff) = w;
                }
                __builtin_amdgcn_sched_barrier(0);
            }
    }
};
struct EpiConvIn {
    static constexpr bool PERM = true; static constexpr bool HAS_PRE = false;
    bf16_t* BG; bf16_t* Z; const float* rs;
    PG8_LAS float* rsl = nullptr; int pm0 = -1;
    f32x4 ra = {0.f, 0.f, 0.f, 0.f}, rb = {0.f, 0.f, 0.f, 0.f};
    static constexpr bool HAS_PRE2 = true;
    __device__ __forceinline__ void pre(int tid) const { if (pm0 >= 0 && tid < 256) rsl[tid] = rs_from(ra, rb); }
    __device__ __forceinline__ float rsget(const Unit& u, int lrow, int row) const { return (u.pm == pm0) ? rsl[lrow] : row_rs(rs, row); }
    __device__ __forceinline__ void operator()(const f32x4 (&acc)[2][2][4][2], const Unit& u, int wr, int wc, int fr, int fq) const {
        const int row0 = u.pm * BM + wr * 64 + fr;
        if (u.pn < 8) {
            const int col0 = u.pn * BM + wc * 32 + 8 * fq;
#pragma unroll
            for (int ai = 0; ai < 2; ++ai)
#pragma unroll
                for (int m = 0; m < 4; ++m) { bf16_t* rowp = BG + (size_t)(row0 + ai * HALF + m * 16) * D + col0; const float rsv = rsget(u, wr * 64 + fr + ai * HALF + m * 16, row0 + ai * HALF + m * 16);
#pragma unroll
                    for (int bj = 0; bj < 2; ++bj) { const f32x4 v0 = acc[ai][bj][m][0] * rsv, v1 = acc[ai][bj][m][1] * rsv;
                        u32x4 w; w.x = cvt_pk_bf16(v0[0], v0[1]); w.y = cvt_pk_bf16(v0[2], v0[3]); w.z = cvt_pk_bf16(v1[0], v1[1]); w.w = cvt_pk_bf16(v1[2], v1[3]);
                        *(u32x4*)(rowp + bj * HALF) = w; } }
        } else {
            const int col0 = (u.pn - 8) * HALF + wc * 32 + 8 * fq;
#pragma unroll
            for (int ai = 0; ai < 2; ++ai)
#pragma unroll
                for (int m = 0; m < 4; ++m) { bf16_t* rowp = Z + (size_t)(row0 + ai * HALF + m * 16) * D + col0; const float rsv = rsget(u, wr * 64 + fr + ai * HALF + m * 16, row0 + ai * HALF + m * 16), rs2 = rsv * rsv;
                    const f32x4 v0 = acc[ai][0][m][0] * acc[ai][1][m][0] * rs2, v1 = acc[ai][0][m][1] * acc[ai][1][m][1] * rs2;
                    u32x4 w; w.x = cvt_pk_bf16(v0[0], v0[1]); w.y = cvt_pk_bf16(v0[2], v0[3]); w.z = cvt_pk_bf16(v1[0], v1[1]); w.w = cvt_pk_bf16(v1[2], v1[3]);
                    *(u32x4*)rowp = w; }
        }
    }
};
}

constexpr size_t MiB = 1u << 20;
constexpr size_t WS_CTL = 0, CTL_ZERO_BYTES = 1 * MiB;
constexpr size_t LW_GU1 = 0, LW_D1 = 44 * MiB, LW_GU2 = 66 * MiB, LW_D2 = 110 * MiB, LW_PG = 132 * MiB, LW_PP = 140 * MiB, LW_SIZE = 141 * MiB;
constexpr size_t WS_LW = 1 * MiB;
constexpr size_t NW_IN = 0, NW_OUT = 21 * MiB, NW_W1 = 29 * MiB, NW_W2 = 33 * MiB, NW_BP = 33 * MiB + 512 * 1024, NW_SIZE = 34 * MiB;
constexpr size_t WS_NSA = 565 * MiB;
constexpr size_t WS_CV_IN = 633 * MiB, WS_CV_OUT = 657 * MiB;
constexpr size_t WS_SG_IN = 665 * MiB, WS_SG_OUT = 681 * MiB, WS_SG_WS = 689 * MiB;
constexpr size_t WS_HN = 690 * MiB;
constexpr size_t WS_ACT = 722 * MiB;
constexpr size_t WS_MB = 810 * MiB;
constexpr size_t WS_PROJ = 874 * MiB;
constexpr size_t WS_QR = 958 * MiB;
constexpr size_t WS_KSR = 990 * MiB, WS_KWR = 998 * MiB, WS_VST = 1006 * MiB, WS_VWT = 1014 * MiB;
constexpr size_t WS_HID = 1022 * MiB;
constexpr size_t WS_KC = 1024 * MiB, WS_VCT = 1024 * MiB + 512 * 1024;
constexpr size_t WS_O = 1025 * MiB;
constexpr size_t WS_PB = 1057 * MiB;
constexpr size_t WS_ROPE = 1073 * MiB;
constexpr size_t WS_GATE = 1074 * MiB;
constexpr size_t WS_HB = 1106 * MiB;
constexpr size_t WS_PE = 1138 * MiB;
constexpr size_t WS_END = 1266 * MiB;

constexpr int CW_TMO = 0, CW_BAR = 4096;

constexpr int RING_BYTES = 131072;
constexpr int LDSCTL_OFF = RING_BYTES, MISC_OFF = LDSCTL_OFF + 320;
constexpr int LDS_BYTES = 147456;

#define XB_TMO      128
#define XB_XCNT(j)  (256  + 64 * (j))
#define XB_XSUB(j)  (1280 + 64 * (j))
#define XB_XGEN(j)  (2304 + 64 * (j))
#define XB_TOP      3328
#define XB_TOPGEN   3392
#define XCD_BAR_WORDS 3456
#define XB_SPIN_CAP (1u << 18)
__device__ __forceinline__ unsigned xb_ld(unsigned* p)              { return __hip_atomic_load(p, __ATOMIC_RELAXED, __HIP_MEMORY_SCOPE_AGENT); }
__device__ __forceinline__ unsigned xb_add(unsigned* p, unsigned v) { return __hip_atomic_fetch_add(p, v, __ATOMIC_RELAXED, __HIP_MEMORY_SCOPE_AGENT); }
__device__ __forceinline__ unsigned xb_xcc_id() { return (unsigned)__builtin_amdgcn_s_getreg((3 << 11) | 20) & 0xFu; }
#define XB_SPIN(cond, bar) do { unsigned _sp = 0; while (cond) { __builtin_amdgcn_s_sleep(1); \
    if ((++_sp & 255u) == 0u) { if (xb_ld(&(bar)[XB_TMO])) break; if (_sp > XB_SPIN_CAP) { atomicAdd(&(bar)[XB_TMO], 1u); break; } } } } while (0)
struct XcdBarrier { unsigned* bar; unsigned x; volatile LAS unsigned* st; };
__device__ __forceinline__ XcdBarrier xcd_barrier_post(unsigned* bar, volatile LAS unsigned* st) {
    XcdBarrier b; b.bar = bar; b.x = xb_xcc_id(); b.st = st;
    if (threadIdx.x == 0) (void)xb_add(&bar[XB_XCNT(b.x)], 1u);
    return b;
}
__device__ __forceinline__ void xcd_barrier_complete(unsigned* bar, unsigned x, unsigned& nloc, unsigned& nx) {
    const unsigned G = gridDim.x * gridDim.y * gridDim.z;
    unsigned sum, cnt, mine, sp = 0u;
    for (;;) {
        sum = 0u; cnt = 0u; mine = 0u;
#pragma unroll
        for (unsigned j = 0; j < 16; ++j) { const unsigned c = xb_ld(&bar[XB_XCNT(j)]); sum += c; cnt += (c > 0u) ? 1u : 0u; mine = (j == x) ? c : mine; }
        if (sum == G) break;
        __builtin_amdgcn_s_sleep(1);
        if ((++sp & 255u) == 0u) { if (xb_ld(&bar[XB_TMO])) break; if (sp > XB_SPIN_CAP) { atomicAdd(&bar[XB_TMO], 1u); break; } }
    }
    nloc = mine > 0u ? mine : 1u; nx = cnt > 0u ? cnt : 1u;
}
__device__ __forceinline__ void xcd_barrier(const XcdBarrier& b) {
    asm volatile("s_waitcnt vmcnt(0)" ::: "memory");
    __syncthreads();
    if (threadIdx.x == 0) {
        unsigned* bar = b.bar;
        __builtin_amdgcn_s_waitcnt(0);
        unsigned nloc = b.st[0], nx = b.st[1];
        if (nloc == 0u) { xcd_barrier_complete(bar, b.x, nloc, nx); b.st[0] = nloc; b.st[1] = nx; }
        const unsigned old = xb_add(&bar[XB_XSUB(b.x)], 1u);
        const unsigned gen = old / nloc;
        if (old + 1u == (gen + 1u) * nloc) {
            __builtin_amdgcn_fence(__ATOMIC_RELEASE, "agent");
            asm volatile("s_waitcnt vmcnt(0)" ::: "memory");
            const unsigned og = xb_add(&bar[XB_TOP], 1u);
            const unsigned tg = og / nx;
            if (og + 1u == (tg + 1u) * nx) xb_add(&bar[XB_TOPGEN], 1u);
            else XB_SPIN(xb_ld(&bar[XB_TOPGEN]) == tg, bar);
            __builtin_amdgcn_fence(__ATOMIC_ACQUIRE, "agent");
            xb_add(&bar[XB_XGEN(b.x)], 1u);
            asm volatile("s_waitcnt vmcnt(0)" ::: "memory");
        } else {
            XB_SPIN(xb_ld(&bar[XB_XGEN(b.x)]) == gen, bar);
            __builtin_amdgcn_fence(__ATOMIC_ACQUIRE, "agent");
            asm volatile("s_waitcnt vmcnt(0)" ::: "memory");
        }
    }
    __syncthreads();
}

constexpr int CW_NORM = 16384;
constexpr int EPI_RED_OFF = 131072 + 2048;
namespace pg8 {
#define EPI_BAR() do { asm volatile("s_waitcnt lgkmcnt(0)" ::: "memory"); __builtin_amdgcn_s_barrier(); asm volatile("" ::: "memory"); } while (0)
template <bool PLE> struct EpiNorm {
    static constexpr bool PERM = true; static constexpr bool HAS_PRE = false;
    bf16_t* H; const float* gpost; float alpha;
    float* ssm; float* ssh; unsigned* cnt; unsigned* bar;
    float* fout; unsigned char* hq8;
    PG8_LAS float* red; int tid;
    const bf16_t* pe; const float* rs;
    __device__ __forceinline__ void operator()(const f32x4 (&acc)[2][2][4][2], const Unit& u, int wr, int wc, int fr, int fq) const {
        const int lrow0 = wr * 64 + fr, col0 = u.pn * BM + wc * 32 + 8 * fq;
        f32x4 g[2][2];
        if constexpr (!PLE) {
#pragma unroll
            for (int bj = 0; bj < 2; ++bj) { g[bj][0] = *(const f32x4*)(gpost + col0 + bj * HALF); g[bj][1] = *(const f32x4*)(gpost + col0 + bj * HALF + 4); }
        }
        u32x4 hw[2][4][2];
        u32x4 yp[2][4][2];
        if constexpr (!PLE) {
#pragma unroll
            for (int m = 0; m < 4; ++m)
#pragma unroll
                for (int bj = 0; bj < 2; ++bj) hw[0][m][bj] = *(const u32x4*)(H + (size_t)(u.pm * BM + lrow0 + 16 * m) * 2048 + col0 + bj * HALF);
        }
#pragma unroll
        for (int ai = 0; ai < 2; ++ai) {
            u32x4 pv[4][2]; float rsv[4];
            if constexpr (PLE) {
#pragma unroll
                for (int m = 0; m < 4; ++m) { const int row = u.pm * BM + ai * HALF + lrow0 + 16 * m; rsv[m] = row_rs(rs, row);
#pragma unroll
                    for (int bj = 0; bj < 2; ++bj) pv[m][bj] = *(const u32x4*)(pe + (size_t)row * 2048 + col0 + bj * HALF); }
            }
#pragma unroll
            for (int m = 0; m < 4; ++m) { float s = 0.f;
                if constexpr (PLE) {
#pragma unroll
                    for (int bj = 0; bj < 2; ++bj) { const u32x4 p = pv[m][bj];
                        const f32x4 p0 = {__uint_as_float(p.x << 16), __uint_as_float(p.x & 0xffff0000u), __uint_as_float(p.y << 16), __uint_as_float(p.y & 0xffff0000u)};
                        const f32x4 p1 = {__uint_as_float(p.z << 16), __uint_as_float(p.z & 0xffff0000u), __uint_as_float(p.w << 16), __uint_as_float(p.w & 0xffff0000u)};
                        f32x4 v0 = acc[ai][bj][m][0] * rsv[m], v1 = acc[ai][bj][m][1] * rsv[m];
                        v0 = (f32x4){fast_sigmoid(v0[0]), fast_sigmoid(v0[1]), fast_sigmoid(v0[2]), fast_sigmoid(v0[3])} * p0; v1 = (f32x4){fast_sigmoid(v1[0]), fast_sigmoid(v1[1]), fast_sigmoid(v1[2]), fast_sigmoid(v1[3])} * p1;
#pragma unroll
                        for (int e = 0; e < 4; ++e) s += v0[e] * v0[e] + v1[e] * v1[e];
                        u32x4 w; w.x = cvt_pk_bf16(v0[0], v0[1]); w.y = cvt_pk_bf16(v0[2], v0[3]); w.z = cvt_pk_bf16(v1[0], v1[1]); w.w = cvt_pk_bf16(v1[2], v1[3]); yp[ai][m][bj] = w; }
                } else {
#pragma unroll
                for (int bj = 0; bj < 2; ++bj)
#pragma unroll
                    for (int n = 0; n < 2; ++n)
#pragma unroll
                        for (int e = 0; e < 4; ++e) s += acc[ai][bj][m][n][e] * acc[ai][bj][m][n][e];
                }
                auto r = __builtin_amdgcn_permlane16_swap(__float_as_uint(s), __float_as_uint(s), false, false); s = __uint_as_float(r[0]) + __uint_as_float(r[1]);
                auto q = __builtin_amdgcn_permlane32_swap(__float_as_uint(s), __float_as_uint(s), false, false); s = __uint_as_float(q[0]) + __uint_as_float(q[1]);
                if (fq == 0) red[wc * 256 + ai * HALF + lrow0 + 16 * m] = s; }
        }
        EPI_BAR();
        if (tid < 256) { const float v = (red[tid] + red[256 + tid]) + (red[512 + tid] + red[768 + tid]);
            __hip_atomic_store(ssm + (size_t)(u.pm * BM + tid) * 8 + u.pn, v, __ATOMIC_RELAXED, __HIP_MEMORY_SCOPE_AGENT); }
        asm volatile("s_waitcnt vmcnt(0)" ::: "memory");
        EPI_BAR();
        if (tid == 0) { unsigned* c = cnt + u.pm * 16; (void)xb_add(c, 1u); XB_SPIN(xb_ld(c) < 8u, bar); }
        EPI_BAR();
        if (tid < 256) { const float* p = ssm + (size_t)(u.pm * BM + tid) * 8; float v[8];
#pragma unroll
            for (int j = 0; j < 8; ++j) v[j] = __hip_atomic_load(p + j, __ATOMIC_RELAXED, __HIP_MEMORY_SCOPE_AGENT);
            red[1024 + tid] = alpha * __builtin_amdgcn_rsqf((((v[0] + v[1]) + (v[2] + v[3])) + ((v[4] + v[5]) + (v[6] + v[7]))) * (1.0f / 2048.0f) + 1e-6f); }
        EPI_BAR();
        if constexpr (PLE) {
#pragma unroll
            for (int bj = 0; bj < 2; ++bj) { g[bj][0] = *(const f32x4*)(gpost + col0 + bj * HALF); g[bj][1] = *(const f32x4*)(gpost + col0 + bj * HALF + 4); }
        }
#pragma unroll
        for (int ai = 0; ai < 2; ++ai)
#pragma unroll
            for (int m = 0; m < 4; ++m) { const int lrow = ai * HALF + lrow0 + 16 * m; const size_t off = (size_t)(u.pm * BM + lrow) * 2048 + col0; const float r = red[1024 + lrow]; float s2 = 0.f;
                if (PLE ? (m == 0) : (ai == 0 && m == 2)) { const int a2 = PLE ? ai : 1;
#pragma unroll
                    for (int m2 = 0; m2 < 4; ++m2)
#pragma unroll
                        for (int bj = 0; bj < 2; ++bj) hw[a2][m2][bj] = *(const u32x4*)(H + (size_t)(u.pm * BM + a2 * HALF + lrow0 + 16 * m2) * 2048 + col0 + bj * HALF);
                }
#pragma unroll
                for (int bj = 0; bj < 2; ++bj) { const unsigned hh[4] = {hw[ai][m][bj].x, hw[ai][m][bj].y, hw[ai][m][bj].z, hw[ai][m][bj].w}; float hv[8];
#pragma unroll
                    for (int e = 0; e < 4; ++e) { hv[2 * e] = __uint_as_float(hh[e] << 16); hv[2 * e + 1] = __uint_as_float(hh[e] & 0xffff0000u); }
                    f32x4 v0, v1;
                    if constexpr (PLE) { const u32x4 y = yp[ai][m][bj];
                        v0 = (f32x4){__uint_as_float(y.x << 16), __uint_as_float(y.x & 0xffff0000u), __uint_as_float(y.y << 16), __uint_as_float(y.y & 0xffff0000u)};
                        v1 = (f32x4){__uint_as_float(y.z << 16), __uint_as_float(y.z & 0xffff0000u), __uint_as_float(y.w << 16), __uint_as_float(y.w & 0xffff0000u)}; }
                    else { v0 = acc[ai][bj][m][0]; v1 = acc[ai][bj][m][1]; }
#pragma unroll
                    for (int e = 0; e < 4; ++e) { hv[e] += v0[e] * r * g[bj][0][e]; hv[4 + e] += v1[e] * r * g[bj][1][e]; }
#pragma unroll
                    for (int e = 0; e < 8; ++e) s2 += hv[e] * hv[e];
                    if (fout) { *(f32x4*)(fout + off + bj * HALF) = (f32x4){hv[0], hv[1], hv[2], hv[3]}; *(f32x4*)(fout + off + bj * HALF + 4) = (f32x4){hv[4], hv[5], hv[6], hv[7]}; }
                    else { u32x4 o; o.x = cvt_pk_bf16(hv[0], hv[1]); o.y = cvt_pk_bf16(hv[2], hv[3]); o.z = cvt_pk_bf16(hv[4], hv[5]); o.w = cvt_pk_bf16(hv[6], hv[7]);
                        *(u32x4*)(H + off + bj * HALF) = o;
                        if (hq8) { float c[8];
#pragma unroll
                            for (int e = 0; e < 8; ++e) c[e] = fminf(fmaxf(hv[e] * 8.0f, -448.0f), 448.0f);
                            int w0 = 0, w1 = 0;
                            w0 = __builtin_amdgcn_cvt_pk_fp8_f32(c[0], c[1], w0, false); w0 = __builtin_amdgcn_cvt_pk_fp8_f32(c[2], c[3], w0, true);
                            w1 = __builtin_amdgcn_cvt_pk_fp8_f32(c[4], c[5], w1, false); w1 = __builtin_amdgcn_cvt_pk_fp8_f32(c[6], c[7], w1, true);
                            u32x2 w; w.x = (unsigned)w0; w.y = (unsigned)w1; *(u32x2*)(hq8 + off + bj * HALF) = w; } } }
                auto r1 = __builtin_amdgcn_permlane16_swap(__float_as_uint(s2), __float_as_uint(s2), false, false); s2 = __uint_as_float(r1[0]) + __uint_as_float(r1[1]);
                auto q1 = __builtin_amdgcn_permlane32_swap(__float_as_uint(s2), __float_as_uint(s2), false, false); s2 = __uint_as_float(q1[0]) + __uint_as_float(q1[1]);
                if (fq == 0) red[wc * 256 + lrow] = s2; }
        EPI_BAR();
        if (ssh && tid < 256) ssh[(size_t)(u.pm * BM + tid) * 8 + u.pn] = (red[tid] + red[256 + tid]) + (red[512 + tid] + red[768 + tid]);
    }
};
}

#define LDS_WAIT() asm volatile("s_waitcnt lgkmcnt(0)" ::: "memory")
__device__ __forceinline__ unsigned f2bf(float f) { unsigned u = __builtin_bit_cast(unsigned, f); return (u + 0x7fffu + ((u >> 16) & 1u)) >> 16; }
__device__ __forceinline__ unsigned pk2(float lo, float hi) { return pg8::cvt_pk_bf16(lo, hi); }
__device__ __forceinline__ float bf_lo(unsigned w) { return __uint_as_float(w << 16); }
__device__ __forceinline__ float bf_hi(unsigned w) { return __uint_as_float(w & 0xffff0000u); }
__device__ __forceinline__ float wave_sum(float v) {
    v += __uint_as_float(__builtin_amdgcn_update_dpp(0u, __float_as_uint(v), 0xB1, 0xF, 0xF, false));
    v += __uint_as_float(__builtin_amdgcn_update_dpp(0u, __float_as_uint(v), 0x4E, 0xF, 0xF, false));
    v += __uint_as_float(__builtin_amdgcn_update_dpp(0u, __float_as_uint(v), 0x141, 0xF, 0xF, false));
    v += __uint_as_float(__builtin_amdgcn_update_dpp(0u, __float_as_uint(v), 0x140, 0xF, 0xF, false));
    auto r = __builtin_amdgcn_permlane16_swap(__float_as_uint(v), __float_as_uint(v), false, false); v = __uint_as_float(r[0]) + __uint_as_float(r[1]);
    auto q = __builtin_amdgcn_permlane32_swap(__float_as_uint(v), __float_as_uint(v), false, false); return __uint_as_float(q[0]) + __uint_as_float(q[1]);
}

struct Ctx {
    LAS unsigned char* lds;
    int tid, lane, wave, G, wg;
};
constexpr int PTR_OFF = 131072 + 1024;
__device__ __forceinline__ const float* inp(const Ctx& F, int i) {
    const unsigned long long v = *(const LAS unsigned long long*)(F.lds + PTR_OFF + 8 * i);
    const unsigned lo = __builtin_amdgcn_readfirstlane((unsigned)v), hi = __builtin_amdgcn_readfirstlane((unsigned)(v >> 32));
    return (const float*)(((unsigned long long)hi << 32) | lo);
}
#define F_WS(F)  ((unsigned char*)inp(F, 27))
#define F_OUT(F) ((float*)inp(F, 26))
#define F_GW(F)  ((F).wg * 8 + (F).wave)
#define F_NGW(F) ((F).G * 8)
enum { I_X = 0, I_P, I_NG, I_F1G, I_F1U, I_F1D, I_F2G, I_F2U, I_F2D, I_PLG, I_PLP, I_NIN, I_NOUT, I_PE, I_PW1, I_PB1, I_PW2, I_CIN, I_CW, I_COUT, I_SIN, I_SLG, I_SLB, I_SWS, I_SBS, I_SOUT };

__device__ __forceinline__ void p0_transpose_block(const float* W, int K, int ldw, int nvalid, bf16_t* WT, int k0, int n0, int drow0, LAS unsigned* scr, int lane, const float* gk) {
    const int nq = lane & 15, kr = lane >> 4, nn = n0 + 4 * nq; const bool ok = nn < nvalid;
    const float* src = W + (size_t)(k0 + 2 * kr) * ldw + nn;
    f32x4 a[8], b[8];
#pragma unroll
    for (int j = 0; j < 8; ++j) { a[j] = ok ? __builtin_nontemporal_load((const GAS f32x4*)(src + (size_t)(8 * j) * ldw)) : (f32x4){0.f, 0.f, 0.f, 0.f}; b[j] = ok ? __builtin_nontemporal_load((const GAS f32x4*)(src + (size_t)(8 * j + 1) * ldw)) : (f32x4){0.f, 0.f, 0.f, 0.f}; }
    if (gk) {
#pragma unroll
        for (int j = 0; j < 8; ++j) { const f32x2 gg = *(const GAS f32x2*)(gk + k0 + 8 * j + 2 * kr); a[j] = a[j] * gg[0]; b[j] = b[j] * gg[1]; }
    }
#pragma unroll
    for (int j = 0; j < 8; ++j)
#pragma unroll
        for (int e = 0; e < 4; ++e) scr[(4 * nq + e) * 36 + 4 * j + kr] = pk2(a[j][e], b[j][e]);
    LDS_WAIT(); asm volatile("" ::: "memory");
#pragma unroll
    for (int i = 0; i < 8; ++i) { const int id = lane + 64 * i, n = id >> 3, c = id & 7;
        const u32x4 v = *(const LAS u32x4*)(scr + n * 36 + 4 * c);
        __builtin_nontemporal_store(v, (GAS u32x4*)(WT + (size_t)(drow0 + n) * K + k0 + 8 * c)); }
    LDS_WAIT(); asm volatile("" ::: "memory");
}
__device__ __forceinline__ void p0_transpose_block_f8(const float* W, int K, int ldw, unsigned char* WT8, int k0, int n0, int drow0, LAS unsigned* scr, int lane, const float* gk) {
    const int nq = lane & 15, kr = lane >> 4;
    const float* src = W + (size_t)(k0 + 4 * kr) * ldw + n0 + 4 * nq;
    f32x4 v[4][4];
#pragma unroll
    for (int j = 0; j < 4; ++j)
#pragma unroll
        for (int r = 0; r < 4; ++r) v[j][r] = __builtin_nontemporal_load((const GAS f32x4*)(src + (size_t)(16 * j + r) * ldw));
    if (gk) {
#pragma unroll
        for (int j = 0; j < 4; ++j) { const f32x4 gg = *(const GAS f32x4*)(gk + k0 + 16 * j + 4 * kr);
#pragma unroll
            for (int r = 0; r < 4; ++r) v[j][r] = v[j][r] * gg[r]; }
    }
#pragma unroll
    for (int j = 0; j < 4; ++j)
#pragma unroll
        for (int e = 0; e < 4; ++e) { int w = 0;
            const float x0 = fminf(fmaxf(v[j][0][e] * 64.0f, -448.0f), 448.0f), x1 = fminf(fmaxf(v[j][1][e] * 64.0f, -448.0f), 448.0f);
            const float x2 = fminf(fmaxf(v[j][2][e] * 64.0f, -448.0f), 448.0f), x3 = fminf(fmaxf(v[j][3][e] * 64.0f, -448.0f), 448.0f);
            w = __builtin_amdgcn_cvt_pk_fp8_f32(x0, x1, w, false); w = __builtin_amdgcn_cvt_pk_fp8_f32(x2, x3, w, true);
            scr[(4 * nq + e) * 20 + 4 * j + kr] = (unsigned)w; }
    LDS_WAIT(); asm volatile("" ::: "memory");
#pragma unroll
    for (int i = 0; i < 4; ++i) { const int id = lane + 64 * i, n = id >> 2, c = id & 3;
        const u32x4 x = *(const LAS u32x4*)(scr + n * 20 + 4 * c);
        __builtin_nontemporal_store(x, (GAS u32x4*)(WT8 + (size_t)(drow0 + n) * K + k0 + 16 * c)); }
    LDS_WAIT(); asm volatile("" ::: "memory");
}
__device__ __forceinline__ void p0_matrix_item_f8(const float* W, int K, int N, unsigned char* WT8, int mode, int r, LAS unsigned* scr, int lane, const float* gk) {
    const int nblk = N / 64, kb = r / nblk, nb = r % nblk, k0 = 64 * kb, n0 = 64 * nb;
    int drow0 = n0;
    if (mode == 1) drow0 = (n0 >> 7) * 256 + (n0 & 127);
    else if (mode == 2) drow0 = (n0 >> 7) * 256 + 128 + (n0 & 127);
    p0_transpose_block_f8(W, K, N, WT8, k0, n0, drow0, scr, lane, gk);
}
__device__ __forceinline__ void p0_matrix_item(const float* W, int K, int N, int Np, bf16_t* WT, int mode, int r, LAS unsigned* scr, int lane, const float* gk) {
    const int nblk = Np / 64, kb = r / nblk, nb = r % nblk, k0 = 64 * kb, n0 = 64 * nb;
    int drow0 = n0;
    if (mode == 1) drow0 = (n0 >> 7) * 256 + (n0 & 127);
    else if (mode == 2) drow0 = (n0 >> 7) * 256 + 128 + (n0 & 127);
    else if (mode == 3) { if (n0 >= 4096) { const int n2 = n0 - 4096; drow0 = 2048 + (n2 >> 7) * 256 + 128 + (n2 & 127); } else if (n0 >= 2048) { const int n1 = n0 - 2048; drow0 = 2048 + (n1 >> 7) * 256 + (n1 & 127); } }
    p0_transpose_block(W, K, N, N, WT, k0, n0, drow0, scr, lane, gk);
}
__device__ __forceinline__ void p0_prologue(Ctx& F) {
    unsigned char* const ws_ = F_WS(F);
    LAS unsigned* scr = (LAS unsigned*)(F.lds + F.wave * 16384);
    const int lane = F.lane;
    unsigned char* ws = ws_;
    const float* const NGp = inp(F, I_NG);
#define GN(L_, i_) (NGp + ((size_t)(L_) * 8 + (i_)) * D)
    constexpr int IT_FF = 2816, IT_PG = 1024, IT_PP = 128, IT_LAYER = 6 * IT_FF + IT_PG + IT_PP;
    constexpr int IT_NIN = 32 * (NSA_NP / 64), IT_NOUT = 1024, IT_W1 = 64 * 4, IT_W2 = 4 * 2, IT_NSA = IT_NIN + IT_NOUT + 2 * IT_W1 + 2 * IT_W2;
    constexpr int IT_CIN = 32 * 96, IT_COUT = 1024, IT_SIN = 32 * 64, IT_SOUT = 1024;
    constexpr int T0 = DEPTH * IT_LAYER, T1 = T0 + 2 * IT_NSA, T2 = T1 + IT_CIN + IT_COUT, T3 = T2 + IT_SIN + IT_SOUT;
    for (int it = F_GW(F); it < T3; it += F_NGW(F)) {
        if (it < T0) {
            const int L = it / IT_LAYER; int r = it % IT_LAYER; unsigned char* lw = ws + WS_LW + (size_t)L * LW_SIZE;
            if (r < 6 * IT_FF) { const int mi = r / IT_FF; r %= IT_FF;
                const size_t woff = (size_t)L * D * FF;
                const int hsw = 2 * L + (mi >= 3 ? 1 : 0);
                const bool f8 = ((mi == 2 || mi == 5) ? D_F8(hsw) : GU_F8(hsw)) != 0u;
                if (f8) {
                    if (mi == 0) p0_matrix_item_f8(inp(F, I_F1G) + woff, D, FF, lw + LW_GU1, 1, r, scr, lane, GN(L, 0));
                    else if (mi == 1) p0_matrix_item_f8(inp(F, I_F1U) + woff, D, FF, lw + LW_GU1, 2, r, scr, lane, GN(L, 0));
                    else if (mi == 2) p0_matrix_item_f8(inp(F, I_F1D) + woff, FF, D, lw + LW_D1, 0, r, scr, lane, nullptr);
                    else if (mi == 3) p0_matrix_item_f8(inp(F, I_F2G) + woff, D, FF, lw + LW_GU2, 1, r, scr, lane, GN(L, 4));
                    else if (mi == 4) p0_matrix_item_f8(inp(F, I_F2U) + woff, D, FF, lw + LW_GU2, 2, r, scr, lane, GN(L, 4));
                    else p0_matrix_item_f8(inp(F, I_F2D) + woff, FF, D, lw + LW_D2, 0, r, scr, lane, nullptr);
                } else {
                    if (mi == 0) p0_matrix_item(inp(F, I_F1G) + woff, D, FF, FF, (bf16_t*)(lw + LW_GU1), 1, r, scr, lane, GN(L, 0));
                    else if (mi == 1) p0_matrix_item(inp(F, I_F1U) + woff, D, FF, FF, (bf16_t*)(lw + LW_GU1), 2, r, scr, lane, GN(L, 0));
                    else if (mi == 2) p0_matrix_item(inp(F, I_F1D) + woff, FF, D, D, (bf16_t*)(lw + LW_D1), 0, r, scr, lane, nullptr);
                    else if (mi == 3) p0_matrix_item(inp(F, I_F2G) + woff, D, FF, FF, (bf16_t*)(lw + LW_GU2), 1, r, scr, lane, GN(L, 4));
                    else if (mi == 4) p0_matrix_item(inp(F, I_F2U) + woff, D, FF, FF, (bf16_t*)(lw + LW_GU2), 2, r, scr, lane, GN(L, 4));
                    else p0_matrix_item(inp(F, I_F2D) + woff, FF, D, D, (bf16_t*)(lw + LW_D2), 0, r, scr, lane, nullptr);
                }
            } else { r -= 6 * IT_FF;
                if (r < IT_PG) p0_matrix_item(inp(F, I_PLG) + (size_t)L * D * D, D, D, D, (bf16_t*)(lw + LW_PG), 0, r, scr, lane, GN(L, 6));
                else p0_matrix_item(inp(F, I_PLP) + (size_t)L * PLE * D, PLE, D, D, (bf16_t*)(lw + LW_PP), 0, r - IT_PG, scr, lane, nullptr);
            }
        } else if (it < T1) {
            const int j = (it - T0) / IT_NSA; int r = (it - T0) % IT_NSA; unsigned char* nw = ws + WS_NSA + (size_t)j * NW_SIZE;
            if (r < IT_NIN) { const int nblk = NSA_NP / 64, kb = r / nblk, nb = r % nblk;
                p0_transpose_block(inp(F, I_NIN) + (size_t)j * D * NSA_N, D, NSA_N, NSA_N, (bf16_t*)(nw + NW_IN), 64 * kb, 64 * nb, 64 * nb, scr, lane, GN(3 * j, 2)); }
            else if ((r -= IT_NIN) < IT_NOUT) p0_matrix_item(inp(F, I_NOUT) + (size_t)j * D * D, D, D, D, (bf16_t*)(nw + NW_OUT), 0, r, scr, lane, nullptr);
            else if ((r -= IT_NOUT) < 2 * IT_W1) { const int kv = r / IT_W1; r %= IT_W1;
                p0_matrix_item(inp(F, I_PW1) + (size_t)(j * 2 + kv) * 4096 * 256, 4096, 256, 256, (bf16_t*)(nw + NW_W1) + (size_t)kv * 256 * 4096, 0, r, scr, lane, nullptr); }
            else { r -= 2 * IT_W1; const int kv = r / IT_W2; r %= IT_W2;
                p0_matrix_item(inp(F, I_PW2) + (size_t)(j * 2 + kv) * 256 * 128, 256, 128, 128, (bf16_t*)(nw + NW_W2) + (size_t)kv * 128 * 256, 0, r, scr, lane, nullptr); }
        } else if (it < T2) {
            int r = it - T1;
            if (r < IT_CIN) p0_matrix_item(inp(F, I_CIN), D, 3 * D, 3 * D, (bf16_t*)(ws + WS_CV_IN), 3, r, scr, lane, GN(1, 2));
            else p0_matrix_item(inp(F, I_COUT), D, D, D, (bf16_t*)(ws + WS_CV_OUT), 0, r - IT_CIN, scr, lane, nullptr);
        } else {
            int r = it - T2;
            if (r < IT_SIN) p0_matrix_item(inp(F, I_SIN), D, 2 * D, 2 * D, (bf16_t*)(ws + WS_SG_IN), 0, r, scr, lane, GN(2, 2));
            else p0_matrix_item(inp(F, I_SOUT), D, D, D, (bf16_t*)(ws + WS_SG_OUT), 0, r - IT_SIN, scr, lane, nullptr);
        }
    }
#undef GN
    {
        const size_t n8 = (size_t)DEPTH * M * PLE / 8; const float* p = inp(F, I_P); bf16_t* pb = (bf16_t*)(ws + WS_PB);
        for (size_t i = (size_t)F_GW(F) * 64 + lane; i < n8; i += (size_t)F_NGW(F) * 64) {
            const f32x4 a = *(const GAS f32x4*)(p + i * 8), b = *(const GAS f32x4*)(p + i * 8 + 4);
            u32x4 o; o.x = pk2(a[0], a[1]); o.y = pk2(a[2], a[3]); o.z = pk2(b[0], b[1]); o.w = pk2(b[2], b[3]);
            *(GAS u32x4*)(pb + i * 8) = o; }
    }
    {
        float* tab = (float*)(ws + WS_ROPE);
        for (int i = F_GW(F) * 64 + lane; i < SEQ * 16; i += F_NGW(F) * 64) { const int pos = i >> 4, fi = i & 15;
            const float inv = powf(500000.0f, -(float)fi / 16.0f); const float ang = (float)pos * inv;
            tab[2 * i] = (float)cos((double)ang); tab[2 * i + 1] = (float)sin((double)ang); }
    }
    {
        const float* wsp = inp(F, I_SWS); bf16_t* o = (bf16_t*)(ws + WS_SG_WS);
        for (int i = F_GW(F) * 64 + lane; i < 8 * 128 * 128; i += F_NGW(F) * 64) { const int t = (i >> 7) & 127, s = i & 127; o[i] = (bf16_t)f2bf(s <= t ? wsp[i] : 0.f); }
    }
    {
        for (int it = F_GW(F); it < 2 * 2 * 16 * 4; it += F_NGW(F)) { const int nc = it & 3, sl = (it >> 2) & 15, kv = (it >> 6) & 1, j = it >> 7;
            const float* pe = inp(F, I_PE) + (size_t)(j * 2 + kv) * 4096; const float* w1 = inp(F, I_PW1) + (size_t)(j * 2 + kv) * 4096 * 256;
            const int n = nc * 64 + lane; float s = 0.f;
            for (int k0 = sl * 256; k0 < sl * 256 + 256; k0 += 16) {
                float wv[16], pv[16];
#pragma unroll
                for (int u = 0; u < 16; ++u) { wv[u] = w1[(size_t)(k0 + u) * 256 + n]; pv[u] = pe[k0 + u]; }
#pragma unroll
                for (int u = 0; u < 16; ++u) s += pv[u] * wv[u];
            }
            ((float*)(ws + WS_NSA + (size_t)j * NW_SIZE + NW_BP))[(kv * 16 + sl) * 256 + n] = s; }
    }
}

__device__ __forceinline__ void norm_phase(Ctx& F, const bf16_t* m, const bf16_t* hin, const float* x32, float alpha, const float* gpost, bf16_t* h, float* rstd, float* fout, unsigned char* hq8 = nullptr) {
    const int lane = F.lane;
    f32x4 gp[4][2];
    if (m) {
#pragma unroll
        for (int j = 0; j < 4; ++j) { gp[j][0] = *(const GAS f32x4*)(gpost + 8 * lane + 512 * j); gp[j][1] = *(const GAS f32x4*)(gpost + 8 * lane + 512 * j + 4); }
    }
    for (int row = F_GW(F); row < M; row += F_NGW(F)) {
        const size_t ro = (size_t)row * D;
        float hv[4][8];
        if (m) {
            float v[4][8]; float ss = 0.f;
#pragma unroll
            for (int j = 0; j < 4; ++j) { const u32x4 w = *(const GAS u32x4*)(m + ro + 8 * lane + 512 * j), hw = *(const GAS u32x4*)(hin + ro + 8 * lane + 512 * j);
                const unsigned ww[4] = {w.x, w.y, w.z, w.w}, hh[4] = {hw.x, hw.y, hw.z, hw.w};
#pragma unroll
                for (int e = 0; e < 4; ++e) { v[j][2 * e] = bf_lo(ww[e]); v[j][2 * e + 1] = bf_hi(ww[e]); hv[j][2 * e] = bf_lo(hh[e]); hv[j][2 * e + 1] = bf_hi(hh[e]);
                    ss += v[j][2 * e] * v[j][2 * e] + v[j][2 * e + 1] * v[j][2 * e + 1]; } }
            const float r = alpha * rsqrtf(wave_sum(ss) * (1.0f / D) + EPS);
#pragma unroll
            for (int j = 0; j < 4; ++j) {
#pragma unroll
                for (int e = 0; e < 4; ++e) { hv[j][e] += v[j][e] * r * gp[j][0][e]; hv[j][4 + e] += v[j][4 + e] * r * gp[j][1][e]; } }
        } else {
#pragma unroll
            for (int j = 0; j < 4; ++j) { const f32x4 a = *(const GAS f32x4*)(x32 + ro + 8 * lane + 512 * j), b = *(const GAS f32x4*)(x32 + ro + 8 * lane + 512 * j + 4);
#pragma unroll
                for (int e = 0; e < 4; ++e) { hv[j][e] = a[e]; hv[j][4 + e] = b[e]; } }
        }
        if (fout) {
#pragma unroll
            for (int j = 0; j < 4; ++j) { *(GAS f32x4*)(fout + ro + 8 * lane + 512 * j) = (f32x4){hv[j][0], hv[j][1], hv[j][2], hv[j][3]}; *(GAS f32x4*)(fout + ro + 8 * lane + 512 * j + 4) = (f32x4){hv[j][4], hv[j][5], hv[j][6], hv[j][7]}; }
        } else {
#pragma unroll
            for (int j = 0; j < 4; ++j) { u32x4 o; o.x = pk2(hv[j][0], hv[j][1]); o.y = pk2(hv[j][2], hv[j][3]); o.z = pk2(hv[j][4], hv[j][5]); o.w = pk2(hv[j][6], hv[j][7]);
                *(GAS u32x4*)(h + ro + 8 * lane + 512 * j) = o;
                if (hq8) {
                    float c[8];
#pragma unroll
                    for (int e = 0; e < 8; ++e) c[e] = fminf(fmaxf(hv[j][e] * 8.0f, -448.0f), 448.0f);
                    int w0 = 0, w1 = 0;
                    w0 = __builtin_amdgcn_cvt_pk_fp8_f32(c[0], c[1], w0, false); w0 = __builtin_amdgcn_cvt_pk_fp8_f32(c[2], c[3], w0, true);
                    w1 = __builtin_amdgcn_cvt_pk_fp8_f32(c[4], c[5], w1, false); w1 = __builtin_amdgcn_cvt_pk_fp8_f32(c[6], c[7], w1, true);
                    u32x2 w; w.x = (unsigned)w0; w.y = (unsigned)w1; *(GAS u32x2*)(hq8 + ro + 8 * lane + 512 * j) = w; } }
        }
        if (rstd) {
            float ss = 0.f;
#pragma unroll
            for (int j = 0; j < 4; ++j)
#pragma unroll
                for (int e = 0; e < 8; ++e) ss += hv[j][e] * hv[j][e];
            const float st = wave_sum(ss);
            if (lane == 0) { float z = 0.f; asm volatile("" : "+v"(z));
                *(GAS f32x4*)(rstd + (size_t)row * 8) = (f32x4){st, z, z, z}; *(GAS f32x4*)(rstd + (size_t)row * 8 + 4) = (f32x4){z, z, z, z}; }
        }
    }
}

__device__ __forceinline__ void nsa_prep_phase(Ctx& F) {
    unsigned char* const ws_ = F_WS(F);
    const bf16_t* proj = (const bf16_t*)(ws_ + WS_PROJ); const float* tab = (const float*)(ws_ + WS_ROPE);
    const int lane = F.lane, sub = lane & 15, grp = lane >> 4;
    const int NITEM = M * 8;
    for (int it = (F_GW(F) * 4 + grp); it < NITEM; it += F_NGW(F) * 4) {
        const int row = it >> 3, slot = 16 + (it & 7), b = row >> 12, s = row & 4095;
        const bf16_t* src; bf16_t* dst;
        if (slot < 16) { src = proj + (size_t)row * NSA_NP + OFF_Q + slot * 128; dst = (bf16_t*)(ws_ + WS_QR) + (size_t)row * D + slot * 128; }
        else if (slot < 20) { const int g = slot - 16; src = proj + (size_t)row * NSA_NP + OFF_KS + g * 128; dst = (bf16_t*)(ws_ + WS_KSR) + ((size_t)(b * 4 + g) * SEQ + s) * 128; }
        else { const int g = slot - 20; src = proj + (size_t)row * NSA_NP + OFF_KW + g * 128; dst = (bf16_t*)(ws_ + WS_KWR) + ((size_t)(b * 4 + g) * SEQ + s) * 128; }
        if (sub >= 4) { *(GAS u32x4*)(dst + sub * 8) = *(const GAS u32x4*)(src + sub * 8); }
        else if (sub < 2) {
            const u32x4 a = *(const GAS u32x4*)(src + sub * 8), c = *(const GAS u32x4*)(src + 16 + sub * 8);
            const float* tb = tab + ((size_t)s * 16 + sub * 8) * 2;
            u32x4 o1, o2; unsigned aw[4] = {a.x, a.y, a.z, a.w}, cw[4] = {c.x, c.y, c.z, c.w}, r1[4], r2[4];
#pragma unroll
            for (int e = 0; e < 4; ++e) {
                const f32x4 cs = *(const GAS f32x4*)(tb + 4 * e);
                const float x1a = bf_lo(aw[e]), x1b = bf_hi(aw[e]), x2a = bf_lo(cw[e]), x2b = bf_hi(cw[e]);
                r1[e] = pk2(x1a * cs[0] - x2a * cs[1], x1b * cs[2] - x2b * cs[3]);
                r2[e] = pk2(x2a * cs[0] + x1a * cs[1], x2b * cs[2] + x1b * cs[3]);
            }
            o1.x = r1[0]; o1.y = r1[1]; o1.z = r1[2]; o1.w = r1[3]; o2.x = r2[0]; o2.y = r2[1]; o2.z = r2[2]; o2.w = r2[3];
            *(GAS u32x4*)(dst + sub * 8) = o1; *(GAS u32x4*)(dst + 16 + sub * 8) = o2;
        }
    }
    LAS bf16_t* scr = (LAS bf16_t*)(F.lds + F.wave * 9216);
    for (int it = F_GW(F); it < 2 * 8 * 64 * 2; it += F_NGW(F)) {
        const int dh = it & 1, st = (it >> 1) & 63, bg = (it >> 7) & 7, which = it >> 10, b = bg >> 2, g = bg & 3, s0 = st * 64;
        const bf16_t* src = proj + (size_t)(b * SEQ + s0) * NSA_NP + (which ? OFF_VW : OFF_VS) + g * 128 + dh * 64;
        bf16_t* dst = (bf16_t*)(ws_ + (which ? WS_VWT : WS_VST)) + ((size_t)bg * 128 + dh * 64) * SEQ + s0;
#pragma unroll 4
        for (int i = 0; i < 8; ++i) { const int s = 8 * i + (lane >> 3), c = lane & 7;
            const u32x4 v = *(const GAS u32x4*)(src + (size_t)s * NSA_NP + c * 8); const unsigned w[4] = {v.x, v.y, v.z, v.w};
#pragma unroll
            for (int e = 0; e < 4; ++e) { scr[(8 * c + 2 * e) * 72 + s] = (bf16_t)(w[e] & 0xffffu); scr[(8 * c + 2 * e + 1) * 72 + s] = (bf16_t)(w[e] >> 16); } }
        LDS_WAIT(); asm volatile("" ::: "memory");
#pragma unroll 4
        for (int i = 0; i < 8; ++i) { const int id = lane + 64 * i, d = id >> 3, sc = id & 7;
            const u32x4 v = *(const LAS u32x4*)(scr + d * 72 + sc * 8);
            *(GAS u32x4*)(dst + (size_t)d * SEQ + sc * 8) = v; }
        LDS_WAIT(); asm volatile("" ::: "memory");
    }
}

__device__ __forceinline__ void nsa_cmp_hidden_phase(Ctx& F, int j) {
    unsigned char* const ws_ = F_WS(F);
    const bf16_t* proj = (const bf16_t*)(ws_ + WS_PROJ);
    const unsigned char* nw = ws_ + WS_NSA + (size_t)j * NW_SIZE;
    const int tid = F.tid, lane = F.lane, wave = F.wave, fr = lane & 15, fq = lane >> 4, wr = wave >> 2, wc = wave & 3;
    constexpr int ACS = 1040, AIMG = 16 * ACS;
    LAS unsigned char* lA = F.lds, * lB = F.lds + 2 * AIMG;
    const int srow = ((tid >> 6) & 3) * 16 + (tid & 15), scol = (tid >> 8) * 4 + ((tid >> 4) & 3);
    for (int u = F.wg; u < 256; u += F.G) {
        const int nt4 = u & 3, ct4 = (u >> 2) & 3, bg = (u >> 4) & 7, kv = u >> 7, b = bg >> 2, g = bg & 3, c0 = ct4 * 64, n0 = nt4 * 64;
        const bf16_t* abase = proj + (size_t)(b * SEQ) * NSA_NP + (kv ? OFF_VC : OFF_KC) + g * 128;
        const bf16_t* aSrc = abase + (size_t)(16 * (c0 + srow)) * NSA_NP + scol * 8;
        const bf16_t* aX = abase + (size_t)(16 * (c0 + 64) + (tid >> 4)) * NSA_NP + (tid & 15) * 8;
        const bf16_t* bSrc = (const bf16_t*)(nw + NW_W1) + (size_t)kv * 256 * 4096 + (size_t)(n0 + srow) * 4096 + scol * 8;
        f32x4 acc[2] = {{0.f, 0.f, 0.f, 0.f}, {0.f, 0.f, 0.f, 0.f}};
        u32x4 pa[2][2][2], pb[2][4][2], px[2] = {{0u, 0u, 0u, 0u}, {0u, 0u, 0u, 0u}};
#define CMP_LOAD(set_, i_) do { \
            _Pragma("unroll") for (int q = 0; q < 2; ++q) { const bf16_t* a2 = aSrc + (size_t)((i_) + q) * NSA_NP; pa[set_][q][0] = *(const GAS u32x4*)(a2); pa[set_][q][1] = *(const GAS u32x4*)(a2 + 64); } \
            if (tid < 32) px[set_] = *(const GAS u32x4*)(aX + (size_t)(i_) * NSA_NP); \
            _Pragma("unroll") for (int q = 0; q < 4; ++q) { const bf16_t* b2 = bSrc + ((i_) + (q & 1) + 16 * (q >> 1)) * 128; pb[set_][q][0] = *(const GAS u32x4*)(b2); pb[set_][q][1] = *(const GAS u32x4*)(b2 + 64); } } while (0)
#define CMP_STEP(set_, i_) do { \
            __syncthreads(); \
            _Pragma("unroll") for (int q = 0; q < 2; ++q) { *(LAS u32x4*)(lA + q * AIMG + scol * ACS + srow * 16) = pa[set_][q][0]; *(LAS u32x4*)(lA + q * AIMG + (scol + 8) * ACS + srow * 16) = pa[set_][q][1]; } \
            if (tid < 32) *(LAS u32x4*)(lA + (tid >> 4) * AIMG + (tid & 15) * ACS + 64 * 16) = px[set_]; \
            _Pragma("unroll") for (int q = 0; q < 4; ++q) { *(LAS u32x4*)(lB + q * 16384 + scol * 1024 + srow * 16) = pb[set_][q][0]; *(LAS u32x4*)(lB + q * 16384 + (scol + 8) * 1024 + srow * 16) = pb[set_][q][1]; } \
            __syncthreads(); \
            if ((i_) + 4 < 16) CMP_LOAD(set_, (i_) + 4); \
            _Pragma("unroll") for (int q = 0; q < 4; ++q)                \
            _Pragma("unroll") for (int ks = 0; ks < 4; ++ks) { \
                const bf16x8 bf = *(const LAS bf16x8*)(lB + q * 16384 + (ks * 4 + fq) * 1024 + (wc * 16 + fr) * 16); \
                _Pragma("unroll") for (int mt = 0; mt < 2; ++mt) { const bf16x8 af = *(const LAS bf16x8*)(lA + (q & 1) * AIMG + (ks * 4 + fq) * ACS + (wr * 32 + mt * 16 + fr + (q >> 1)) * 16); \
                    acc[mt] = __builtin_amdgcn_mfma_f32_16x16x32_bf16(bf, af, acc[mt], 0, 0, 0); } } } while (0)
        CMP_LOAD(0, 0); CMP_LOAD(1, 2);
        for (int i = 0; i < 16; i += 4) { CMP_STEP(0, i); CMP_STEP(1, i + 2); }
#undef CMP_LOAD
#undef CMP_STEP
        const float* b1p = inp(F, I_PB1) + (size_t)(j * 2 + kv) * 256; const float* bp = (const float*)(nw + NW_BP) + (size_t)kv * 16 * 256;
        const int nn = n0 + wc * 16 + 4 * fq; float bias[4];
#pragma unroll
        for (int e = 0; e < 4; ++e) { bias[e] = b1p[nn + e];
#pragma unroll
            for (int sl = 0; sl < 16; ++sl) bias[e] += bp[sl * 256 + nn + e]; }
#pragma unroll
        for (int mt = 0; mt < 2; ++mt) { const int c = c0 + wr * 32 + mt * 16 + fr; float o[4];
#pragma unroll
            for (int e = 0; e < 4; ++e) { o[e] = pg8::silu_f(acc[mt][e] + bias[e]); if (c == 255) o[e] = 0.f; }
            u32x2 w; w.x = pk2(o[0], o[1]); w.y = pk2(o[2], o[3]);
            *(GAS u32x2*)((bf16_t*)(ws_ + WS_HID) + ((size_t)(kv * 8 + bg) * 256 + c) * 256 + nn) = w; }
    }
    __syncthreads();
}
__device__ __forceinline__ void nsa_cmp_out_phase(Ctx& F, int j) {
    unsigned char* const ws_ = F_WS(F);
    const unsigned char* nw = ws_ + WS_NSA + (size_t)j * NW_SIZE;
    const int lane = F.lane, fr = lane & 15, fq = lane >> 4;
    for (int it = F_GW(F); it < 2 * 8 * 16 * 2; it += F_NGW(F)) {
        const int dq = it & 1, ct = (it >> 1) & 15, bg = (it >> 5) & 7, kv = it >> 8;
        const bf16_t* hid = (const bf16_t*)(ws_ + WS_HID) + ((size_t)(kv * 8 + bg) * 256 + ct * 16 + fr) * 256 + 8 * fq;
        const bf16_t* w2t = (const bf16_t*)(nw + NW_W2) + (size_t)kv * 128 * 256 + (size_t)(dq * 64 + fr) * 256 + 8 * fq;
        f32x4 acc[4];
#pragma unroll
        for (int nt = 0; nt < 4; ++nt) acc[nt] = (f32x4){0.f, 0.f, 0.f, 0.f};
#pragma unroll
        for (int ks = 0; ks < 8; ++ks) {
            const bf16x8 af = *(const GAS bf16x8*)(hid + ks * 32);
#pragma unroll
            for (int nt = 0; nt < 4; ++nt) { const bf16x8 bf = *(const GAS bf16x8*)(w2t + (size_t)nt * 16 * 256 + ks * 32);
                if (kv == 0) acc[nt] = __builtin_amdgcn_mfma_f32_16x16x32_bf16(bf, af, acc[nt], 0, 0, 0);
                else acc[nt] = __builtin_amdgcn_mfma_f32_16x16x32_bf16(af, bf, acc[nt], 0, 0, 0);
            }
        }
        if (kv == 0) { bf16_t* kc = (bf16_t*)(ws_ + WS_KC) + ((size_t)bg * 256 + ct * 16 + fr) * 128 + dq * 64 + 4 * fq;
#pragma unroll
            for (int nt = 0; nt < 4; ++nt) { u32x2 w; w.x = pk2(acc[nt][0], acc[nt][1]); w.y = pk2(acc[nt][2], acc[nt][3]); *(GAS u32x2*)(kc + nt * 16) = w; }
        } else { bf16_t* vct = (bf16_t*)(ws_ + WS_VCT) + ((size_t)bg * 128 + dq * 64 + fr) * 256 + ct * 16 + 4 * fq;
#pragma unroll
            for (int nt = 0; nt < 4; ++nt) { u32x2 w; w.x = pk2(acc[nt][0], acc[nt][1]); w.y = pk2(acc[nt][2], acc[nt][3]); *(GAS u32x2*)(vct + (size_t)nt * 16 * 256) = w; }
        }
    }
}

namespace att {
constexpr int VP = 144;
constexpr int L_K = 0, L_V = 16384, L_Q = 34816, L_IMP = 100352, L_MASK = 116736;
constexpr float CS = 0.08838834764831845f * 1.4426950408889634f;

__device__ __forceinline__ int launder(int v) { asm volatile("" : "+v"(v)); return v; }
__device__ __forceinline__ float red4_max(float x) {
    auto r = __builtin_amdgcn_permlane16_swap(__float_as_uint(x), __float_as_uint(x), false, false); x = fmaxf(__uint_as_float(r[0]), __uint_as_float(r[1]));
    auto q = __builtin_amdgcn_permlane32_swap(__float_as_uint(x), __float_as_uint(x), false, false); return fmaxf(__uint_as_float(q[0]), __uint_as_float(q[1]));
}
__device__ __forceinline__ float max3(float a, float b, float c) { float r; asm("v_max3_f32 %0, %1, %2, %3" : "=v"(r) : "v"(a), "v"(b), "v"(c)); return r; }
__device__ __forceinline__ float red4_sum(float x) {
    auto r = __builtin_amdgcn_permlane16_swap(__float_as_uint(x), __float_as_uint(x), false, false); x = __uint_as_float(r[0]) + __uint_as_float(r[1]);
    auto q = __builtin_amdgcn_permlane32_swap(__float_as_uint(x), __float_as_uint(x), false, false); return __uint_as_float(q[0]) + __uint_as_float(q[1]);
}
struct Tile { u32x4 k0, k1, v0, v1; };
__device__ __forceinline__ void tile_load(Tile& T, const bf16_t* Kb, const bf16_t* VTb, int vpitch, int key0, int tid) {
    const int c0 = tid, c1 = tid + 512;
    const int key = ((tid >> 6) & 3) * 16 + (tid & 15), col = (tid >> 8) * 4 + ((tid >> 4) & 3);
    T.k0 = *(const GAS u32x4*)(Kb + (size_t)(key0 + key) * 128 + col * 8);
    T.k1 = *(const GAS u32x4*)(Kb + (size_t)(key0 + key) * 128 + (col + 8) * 8);
    T.v0 = *(const GAS u32x4*)(VTb + (size_t)(c0 >> 3) * vpitch + key0 + (c0 & 7) * 8);
    T.v1 = *(const GAS u32x4*)(VTb + (size_t)(c1 >> 3) * vpitch + key0 + (c1 & 7) * 8);
}
__device__ __forceinline__ void tile_store(const Tile& T, LAS unsigned char* lds, int tid) {
    const int c0 = tid, c1 = tid + 512;
    const int key = ((tid >> 6) & 3) * 16 + (tid & 15), col = (tid >> 8) * 4 + ((tid >> 4) & 3);
    *(LAS u32x4*)(lds + L_K + col * 1024 + key * 16) = T.k0;
    *(LAS u32x4*)(lds + L_K + (col + 8) * 1024 + key * 16) = T.k1;
    *(LAS u32x4*)(lds + L_V + (c0 >> 3) * VP + (c0 & 7) * 16) = T.v0;
    *(LAS u32x4*)(lds + L_V + (c1 >> 3) * VP + (c1 & 7) * 16) = T.v1;
}
template <int MODE>
__device__ __forceinline__ void pass(LAS unsigned char* lds, const bf16_t* Kb, const bf16_t* VTb, int vpitch, int kt_lo, int kt_hi, int t0w  ,
                                     f32x4 (&ot)[8][2], float (&mrow)[2], float (&lrow)[2], const unsigned (&mlo)[2], const unsigned (&mhi)[2], int tid_, int wave,
                                     Tile& T, const bf16_t* nKb, const bf16_t* nVTb, int nvp, int nkey0) {
    const int tid = launder(tid_), lane = tid & 63, fr = lane & 15, fq = lane >> 4;
    LAS unsigned char* qb = lds + L_Q + wave * 8192 + fq * 512 + fr * 16;
    LAS unsigned char* kb = lds + L_K + fq * 1024 + fr * 16;
    LAS unsigned char* vb = lds + L_V + fr * VP + fq * 8;
    LAS float* imp = (LAS float*)(lds + L_IMP);
    float bcarry[2] = {0.f, 0.f};
    for (int kt = kt_lo; kt <= kt_hi; ++kt) {
        __syncthreads();
        tile_store(T, lds, tid);
        __syncthreads();
        if (kt < kt_hi) tile_load(T, Kb, VTb, vpitch, (kt + 1) * 64, tid);
        else if (nKb) tile_load(T, nKb, nVTb, nvp, nkey0, tid);
        f32x4 st[4][2];
        {
            bf16x8 qc0 = *(const LAS bf16x8*)(qb), qc1 = *(const LAS bf16x8*)(qb + 256), kc[4];
#pragma unroll
            for (int kk = 0; kk < 4; ++kk) kc[kk] = *(const LAS bf16x8*)(kb + kk * 256);
#pragma unroll
            for (int ks = 0; ks < 4; ++ks) {
                bf16x8 qn0 = qc0, qn1 = qc1, kn[4] = {kc[0], kc[1], kc[2], kc[3]};
                if (ks < 3) { qn0 = *(const LAS bf16x8*)(qb + (ks + 1) * 2048); qn1 = *(const LAS bf16x8*)(qb + (ks + 1) * 2048 + 256);
#pragma unroll
                    for (int kk = 0; kk < 4; ++kk) kn[kk] = *(const LAS bf16x8*)(kb + (ks + 1) * 4096 + kk * 256); }
                __builtin_amdgcn_sched_barrier(0);
#pragma unroll
                for (int kk = 0; kk < 4; ++kk) {
                    st[kk][0] = __builtin_amdgcn_mfma_f32_16x16x32_bf16(kc[kk], qc0, ks ? st[kk][0] : (f32x4){0.f, 0.f, 0.f, 0.f}, 0, 0, 0);
                    st[kk][1] = __builtin_amdgcn_mfma_f32_16x16x32_bf16(kc[kk], qc1, ks ? st[kk][1] : (f32x4){0.f, 0.f, 0.f, 0.f}, 0, 0, 0); }
                __builtin_amdgcn_sched_barrier(0);
                qc0 = qn0; qc1 = qn1;
#pragma unroll
                for (int kk = 0; kk < 4; ++kk) kc[kk] = kn[kk];
            }
        }
        asm volatile("s_nop 7" : "+v"(st[0][0]), "+v"(st[0][1]), "+v"(st[1][0]), "+v"(st[1][1]), "+v"(st[2][0]), "+v"(st[2][1]), "+v"(st[3][0]), "+v"(st[3][1]));
        bool emask;
        if (MODE <= 1) emask = (kt * 1024 + 1039 > t0w);
        else if (MODE == 2) emask = (kt == kt_hi);
        else emask = (kt == kt_hi) || (kt == kt_lo && kt_hi - kt_lo == 8);
        bf16x8 pf[2][2];
#pragma unroll
        for (int qt = 0; qt < 2; ++qt) {
            const int t = t0w + 4 * qt + (fr >> 2);
            float sv[4][4];
            float rowbias = 0.f;
            if (MODE == 2) { const bool sel_ok = (kt < 32) ? ((mlo[qt] >> kt) & 1u) : ((mhi[qt] >> (kt - 32)) & 1u); rowbias = sel_ok ? 0.f : -INFINITY; }
            if (emask) {
#pragma unroll
                for (int kk = 0; kk < 4; ++kk)
#pragma unroll
                    for (int e = 0; e < 4; ++e) {
                        const int key = kt * 64 + kk * 16 + fq * 4 + e; bool ok;
                        if (MODE <= 1) ok = (16 * key + 31 <= t);
                        else if (MODE == 2) ok = (key <= t);
                        else ok = (key <= t) && (t - key < 512);
                        sv[kk][e] = ok ? st[kk][qt][e] : -INFINITY;
                    }
            } else {
#pragma unroll
                for (int kk = 0; kk < 4; ++kk)
#pragma unroll
                    for (int e = 0; e < 4; ++e) sv[kk][e] = st[kk][qt][e];
            }
            if (MODE != 1) {
                float mx = max3(max3(sv[0][0], sv[0][1], sv[0][2]), max3(sv[0][3], sv[1][0], sv[1][1]), max3(sv[1][2], sv[1][3], sv[2][0]));
                mx = max3(mx, max3(sv[2][1], sv[2][2], sv[2][3]), max3(sv[3][0], sv[3][1], max3(sv[3][2], sv[3][3], sv[3][3])));
                mx = red4_max(mx);
                const float mxs = mx * CS + rowbias;
                float alpha = 1.f;
                if (__any(mxs > mrow[qt] + 6.0f)) {
                    const float mnew = fmaxf(mrow[qt], mxs);
                    alpha = __builtin_amdgcn_exp2f(mrow[qt] - mnew);
                    mrow[qt] = mnew;
                    if (MODE != 0) {
#pragma unroll
                        for (int dt = 0; dt < 8; ++dt) ot[dt][qt] = ot[dt][qt] * alpha;
                    }
                }
                const float boff = rowbias - mrow[qt];
                float psum = 0.f;
#pragma unroll
                for (int kk = 0; kk < 4; ++kk)
#pragma unroll
                    for (int e = 0; e < 4; ++e) { const float p = __builtin_amdgcn_exp2f(fmaf(sv[kk][e], CS, boff)); sv[kk][e] = p; psum += p; }
                psum = red4_sum(psum);
                lrow[qt] = lrow[qt] * alpha + psum;
            } else {
                const float boff = -mrow[qt], rinv = lrow[qt];
#pragma unroll
                for (int kk = 0; kk < 4; ++kk) {
#pragma unroll
                    for (int e = 0; e < 4; ++e) sv[kk][e] = __builtin_amdgcn_exp2f(fmaf(sv[kk][e], CS, boff)) * rinv;
                    float a = 2.f * ((sv[kk][0] + sv[kk][1]) + sv[kk][2]) + sv[kk][3], bq = sv[kk][3];
                    a += __shfl_xor(a, 1); a += __shfl_xor(a, 2); bq += __shfl_xor(bq, 1); bq += __shfl_xor(bq, 2);
                    const float bl = __shfl(bq, (lane + 48) & 63);
                    const float bc = __shfl(bcarry[qt], (lane + 48) & 63);
                    const float bprev = fq > 0 ? bl : bc;
                    bcarry[qt] = bq;
                    if ((fr & 3) == 0) imp[((wave * 8 + 4 * qt + (fr >> 2)) << 6) + ((kt * 16 + kk * 4 + fq) & 63)] = a + bprev;
                }
            }
            if (MODE != 0) {
#pragma unroll
                for (int kp = 0; kp < 2; ++kp) {
                    u32x4 w; w.x = pg8::cvt_pk_bf16(sv[2 * kp][0], sv[2 * kp][1]); w.y = pg8::cvt_pk_bf16(sv[2 * kp][2], sv[2 * kp][3]);
                    w.z = pg8::cvt_pk_bf16(sv[2 * kp + 1][0], sv[2 * kp + 1][1]); w.w = pg8::cvt_pk_bf16(sv[2 * kp + 1][2], sv[2 * kp + 1][3]);
                    pf[kp][qt] = __builtin_bit_cast(bf16x8, w);
                }
            }
        }
        if (MODE != 0) {
            u32x2 va[4], vc[4];
#pragma unroll
            for (int i = 0; i < 4; ++i) { va[i] = *(const LAS u32x2*)(vb + i * 16 * VP); vc[i] = *(const LAS u32x2*)(vb + i * 16 * VP + 32); }
#pragma unroll
            for (int grp = 0; grp < 4; ++grp) {
                const int kp = grp >> 1, d0 = (grp & 1) * 4;
                u32x2 na[4] = {va[0], va[1], va[2], va[3]}, nc[4] = {vc[0], vc[1], vc[2], vc[3]};
                if (grp < 3) { const int kp2 = (grp + 1) >> 1, e0 = ((grp + 1) & 1) * 4;
#pragma unroll
                    for (int i = 0; i < 4; ++i) { na[i] = *(const LAS u32x2*)(vb + (e0 + i) * 16 * VP + kp2 * 64); nc[i] = *(const LAS u32x2*)(vb + (e0 + i) * 16 * VP + kp2 * 64 + 32); } }
                __builtin_amdgcn_sched_barrier(0);
#pragma unroll
                for (int i = 0; i < 4; ++i) { u32x4 vw; vw.x = va[i].x; vw.y = va[i].y; vw.z = vc[i].x; vw.w = vc[i].y; const bf16x8 vf = __builtin_bit_cast(bf16x8, vw);
                    ot[d0 + i][0] = __builtin_amdgcn_mfma_f32_16x16x32_bf16(vf, pf[kp][0], ot[d0 + i][0], 0, 0, 0);
                    ot[d0 + i][1] = __builtin_amdgcn_mfma_f32_16x16x32_bf16(vf, pf[kp][1], ot[d0 + i][1], 0, 0, 0); }
                __builtin_amdgcn_sched_barrier(0);
#pragma unroll
                for (int i = 0; i < 4; ++i) { va[i] = na[i]; vc[i] = nc[i]; }
            }
        }
    }
}
__device__ __forceinline__ void load_q(LAS unsigned char* lds, const bf16_t* src  , int pitch, int wave, int lane, const float* tab = nullptr, int pos0 = 0) {
#pragma unroll
    for (int i = 0; i < 8; ++i) { const int c = lane + 64 * i, rr = c >> 4, ch = c & 15;
        const bf16_t* rp = src + (size_t)(rr >> 2) * pitch + (rr & 3) * 128;
        u32x4 v = *(const GAS u32x4*)(rp + ch * 8);
        if (tab && ch < 4) {
            const u32x4 pw = *(const GAS u32x4*)(rp + (ch ^ 2) * 8);
            const float* tb = tab + ((size_t)(pos0 + (rr >> 2)) * 16 + (ch & 1) * 8) * 2;
            const unsigned ow[4] = {v.x, v.y, v.z, v.w}, qw[4] = {pw.x, pw.y, pw.z, pw.w}; unsigned r[4];
#pragma unroll
            for (int e = 0; e < 4; ++e) {
                const f32x4 cs = *(const GAS f32x4*)(tb + 4 * e);
                const float oa = bf_lo(ow[e]), ob = bf_hi(ow[e]), pa = bf_lo(qw[e]), pb = bf_hi(qw[e]);
                r[e] = (ch < 2) ? pk2(oa * cs[0] - pa * cs[1], ob * cs[2] - pb * cs[3])
                                : pk2(oa * cs[0] + pa * cs[1], ob * cs[2] + pb * cs[3]);
            }
            v.x = r[0]; v.y = r[1]; v.z = r[2]; v.w = r[3];
        }
        *(LAS u32x4*)(lds + L_Q + wave * 8192 + ch * 512 + rr * 16) = v; }
}
__device__ __forceinline__ void unit(Ctx& F, int bg, int qb, Tile& T, bool chain) {
    unsigned char* const ws_ = F_WS(F);
    LAS unsigned char* lds = F.lds;
    const int tid = launder(F.tid), wave = F.wave; int lane = tid & 63, fr = lane & 15, fq = lane >> 4;
    const int b = bg >> 2, g = bg & 3, t0w = qb * 64 + wave * 8;
    const bf16_t* proj = (const bf16_t*)(ws_ + WS_PROJ);
    const bf16_t* prow = proj + (size_t)(b * SEQ + t0w) * NSA_NP;
    f32x4 ot[8][2];
    float* MBf = (float*)(ws_ + WS_MB);
    float mrow[2], lrow[2]; unsigned mlo[2] = {0u, 0u}, mhi[2] = {0u, 0u};
    const bf16_t* KCb = (const bf16_t*)(ws_ + WS_KC) + (size_t)bg * 256 * 128; const bf16_t* VCb = (const bf16_t*)(ws_ + WS_VCT) + (size_t)bg * 128 * 256;
    const bf16_t* KSb = (const bf16_t*)(ws_ + WS_KSR) + (size_t)bg * SEQ * 128; const bf16_t* VSb = (const bf16_t*)(ws_ + WS_VST) + (size_t)bg * 128 * SEQ;
    const bf16_t* KWb = (const bf16_t*)(ws_ + WS_KWR) + (size_t)bg * SEQ * 128; const bf16_t* VWb = (const bf16_t*)(ws_ + WS_VWT) + (size_t)bg * 128 * SEQ;
    const int klo = qb >= 8 ? qb - 8 : 0;
    float gate[3][2];
#pragma unroll
    for (int qt = 0; qt < 2; ++qt)
#pragma unroll
        for (int br = 0; br < 3; ++br) { const bf16_t gv = prow[(size_t)(4 * qt + (fr >> 2)) * NSA_NP + OFF_GATE + br * 16 + 4 * g + (fr & 3)];
            gate[br][qt] = pg8::fast_sigmoid(__uint_as_float((unsigned)gv << 16)); }
    __syncthreads();
    load_q(lds, prow + OFF_Q + g * 512, NSA_NP, wave, lane);
    const int nct = (4 * qb + 2) / 64;
    mrow[0] = mrow[1] = -1e30f; lrow[0] = lrow[1] = 0.f;
    pass<0>(lds, KCb, VCb, 256, 0, nct, t0w, ot, mrow, lrow, mlo, mhi, tid, wave, T, KCb, VCb, 256, 0);
#pragma unroll
    for (int qt = 0; qt < 2; ++qt) lrow[qt] = 1.0f / fmaxf(lrow[qt], 1e-30f);
#pragma unroll
    for (int dt = 0; dt < 8; ++dt) { ot[dt][0] = (f32x4){0.f, 0.f, 0.f, 0.f}; ot[dt][1] = (f32x4){0.f, 0.f, 0.f, 0.f}; }
    pass<1>(lds, KCb, VCb, 256, 0, nct, t0w, ot, mrow, lrow, mlo, mhi, tid, wave, T, KSb, VSb, SEQ, 0);
    lane = launder(tid) & 63; fr = lane & 15; fq = lane >> 4;
#pragma unroll
    for (int qt = 0; qt < 2; ++qt) { float* mrowp = MBf + (size_t)(b * SEQ + t0w + 4 * qt + (fr >> 2)) * D + (4 * g + (fr & 3)) * 128 + 4 * fq;
#pragma unroll
        for (int dt = 0; dt < 8; ++dt) *(GAS f32x4*)(mrowp + dt * 16) = ot[dt][qt] * gate[0][qt]; }
    {
        LAS float* imp = (LAS float*)(lds + L_IMP); LAS unsigned* msk = (LAS unsigned*)(lds + L_MASK);
        lane = launder(tid) & 63; fr = lane & 15; fq = lane >> 4;
        LDS_WAIT();
        if (qb <= 15) {
            const unsigned long long mm = (1ull << (qb + 1)) - 1ull;
            mlo[0] = mlo[1] = (unsigned)mm; mhi[0] = mhi[1] = (unsigned)(mm >> 32);
        } else {
            const int jhi = qb - 2;
#pragma nounroll
            for (int i = 0; i < 8; ++i) {
                const int tl = wave * 8 + i;
                const float v = imp[(tl << 6) + lane];
                int cnt = 0;
                for (int j2 = 1; j2 <= jhi; ++j2) { const float v2 = imp[(tl << 6) + j2]; cnt += (v2 > v || (v2 == v && j2 < lane)) ? 1 : 0; }
                const bool sel = (lane >= 1) && (lane <= jhi) && (cnt < 13);
                const unsigned long long bal = __ballot(sel) | 1ull | (1ull << qb) | (1ull << (qb - 1));
                if (lane == 0) { msk[2 * tl] = (unsigned)bal; msk[2 * tl + 1] = (unsigned)(bal >> 32); }
            }
            LDS_WAIT();
#pragma unroll
            for (int qt = 0; qt < 2; ++qt) { const int tl = wave * 8 + 4 * qt + (fr >> 2); mlo[qt] = msk[2 * tl]; mhi[qt] = msk[2 * tl + 1]; }
        }
    }
    lane = launder(tid) & 63; fr = lane & 15; fq = lane >> 4;
    load_q(lds, prow + OFF_Q + g * 512, NSA_NP, wave, lane, (const float*)(ws_ + WS_ROPE), t0w);
    {
        mrow[0] = mrow[1] = -1e30f; lrow[0] = lrow[1] = 0.f;
#pragma unroll
        for (int dt = 0; dt < 8; ++dt) { ot[dt][0] = (f32x4){0.f, 0.f, 0.f, 0.f}; ot[dt][1] = (f32x4){0.f, 0.f, 0.f, 0.f}; }
        pass<2>(lds, KSb, VSb, SEQ, 0, qb, t0w, ot, mrow, lrow, mlo, mhi, tid, wave, T, KWb, VWb, SEQ, klo * 64);
        lane = launder(tid) & 63; fr = lane & 15; fq = lane >> 4;
#pragma unroll
        for (int qt = 0; qt < 2; ++qt) { const float sc = gate[1][qt] / fmaxf(lrow[qt], 1e-30f);
            float* mrowp = MBf + (size_t)(b * SEQ + t0w + 4 * qt + (fr >> 2)) * D + (4 * g + (fr & 3)) * 128 + 4 * fq;
#pragma unroll
            for (int dt = 0; dt < 8; ++dt) { const f32x4 o = *(const GAS f32x4*)(mrowp + dt * 16); *(GAS f32x4*)(mrowp + dt * 16) = o + ot[dt][qt] * sc; } }
    }
    {
        mrow[0] = mrow[1] = -1e30f; lrow[0] = lrow[1] = 0.f;
#pragma unroll
        for (int dt = 0; dt < 8; ++dt) { ot[dt][0] = (f32x4){0.f, 0.f, 0.f, 0.f}; ot[dt][1] = (f32x4){0.f, 0.f, 0.f, 0.f}; }
        pass<3>(lds, KWb, VWb, SEQ, klo, qb, t0w, ot, mrow, lrow, mlo, mhi, tid, wave, T, chain ? KCb : nullptr, VCb, 256, 0);
        bf16_t* O = (bf16_t*)(ws_ + WS_O);
        lane = launder(tid) & 63; fr = lane & 15; fq = lane >> 4;
#pragma unroll
        for (int qt = 0; qt < 2; ++qt) { const float sc = gate[2][qt] / fmaxf(lrow[qt], 1e-30f);
            const size_t ro = (size_t)(b * SEQ + t0w + 4 * qt + (fr >> 2)) * D + (4 * g + (fr & 3)) * 128 + 4 * fq;
#pragma unroll
            for (int dt = 0; dt < 8; ++dt) { const f32x4 o = *(const GAS f32x4*)(MBf + ro + dt * 16) + ot[dt][qt] * sc;
                u32x2 w; w.x = pk2(o[0], o[1]); w.y = pk2(o[2], o[3]); *(GAS u32x2*)(O + ro + dt * 16) = w; } }
    }
}
__device__ __forceinline__ void phase(Ctx& F) {
    if (F.wave >= 4) __builtin_amdgcn_s_setprio(1);
    for (int u2 = 2 * F.wg; u2 < 512; u2 += 2 * F.G) {
        const int u = u2 >> 1, bg = u >> 5, x = u & 31;
        Tile T; { unsigned char* const ws_ = F_WS(F); tile_load(T, (const bf16_t*)(ws_ + WS_KC) + (size_t)bg * 256 * 128, (const bf16_t*)(ws_ + WS_VCT) + (size_t)bg * 128 * 256, 256, 0, launder(F.tid)); }
#pragma nounroll
        for (int k2 = 0; k2 < 2; ++k2) unit(F, bg, k2 ? 63 - x : x, T, k2 == 0); }
    __builtin_amdgcn_s_setprio(0);
    __syncthreads();
}
}

__device__ __forceinline__ void conv_phase(Ctx& F) {
    unsigned char* const ws_ = F_WS(F);
    const bf16_t* BG = (const bf16_t*)(ws_ + WS_PROJ); const bf16_t* Z = BG + (size_t)M * D; bf16_t* O = (bf16_t*)(ws_ + WS_O);
    const float* cw = inp(F, I_CW);
    const size_t n8 = (size_t)M * D / 8;
    for (size_t i = (size_t)F_GW(F) * 64 + F.lane; i < n8; i += (size_t)F_NGW(F) * 64) {
        const int row = (int)(i >> 8), c8 = (int)(i & 255) * 8, s = row & 4095;
        const u32x4 bgv = *(const GAS u32x4*)(BG + (size_t)row * D + c8), z0 = *(const GAS u32x4*)(Z + (size_t)row * D + c8);
        u32x4 z1 = {0u, 0u, 0u, 0u}, z2 = {0u, 0u, 0u, 0u};
        if (s >= 1) z1 = *(const GAS u32x4*)(Z + (size_t)(row - 1) * D + c8);
        if (s >= 2) z2 = *(const GAS u32x4*)(Z + (size_t)(row - 2) * D + c8);
        const unsigned bw[4] = {bgv.x, bgv.y, bgv.z, bgv.w}, a0[4] = {z0.x, z0.y, z0.z, z0.w}, a1[4] = {z1.x, z1.y, z1.z, z1.w}, a2[4] = {z2.x, z2.y, z2.z, z2.w};
        unsigned o[4];
#pragma unroll
        for (int e = 0; e < 4; ++e) {
            const int c = c8 + 2 * e;
            const float lo = bf_lo(bw[e]) * (cw[c] * bf_lo(a2[e]) + cw[D + c] * bf_lo(a1[e]) + cw[2 * D + c] * bf_lo(a0[e]));
            const float hi = bf_hi(bw[e]) * (cw[c + 1] * bf_hi(a2[e]) + cw[D + c + 1] * bf_hi(a1[e]) + cw[2 * D + c + 1] * bf_hi(a0[e]));
            o[e] = pk2(lo, hi);
        }
        u32x4 ov; ov.x = o[0]; ov.y = o[1]; ov.z = o[2]; ov.w = o[3];
        *(GAS u32x4*)(O + (size_t)row * D + c8) = ov;
    }
}

__device__ __forceinline__ void sgu_ln_phase(Ctx& F) {
    unsigned char* const ws_ = F_WS(F);
    const bf16_t* Z2 = (const bf16_t*)(ws_ + WS_PROJ); bf16_t* VLN = (bf16_t*)(ws_ + WS_QR);
    const float* lg = inp(F, I_SLG); const float* lb = inp(F, I_SLB); const int lane = F.lane;
    for (int row = F_GW(F); row < M; row += F_NGW(F)) {
        float v[32]; float s = 0.f;
#pragma unroll
        for (int j = 0; j < 4; ++j) { const u32x4 w = *(const GAS u32x4*)(Z2 + (size_t)row * 4096 + 2048 + 8 * lane + 512 * j); const unsigned ww[4] = {w.x, w.y, w.z, w.w};
#pragma unroll
            for (int e = 0; e < 4; ++e) { v[8 * j + 2 * e] = bf_lo(ww[e]); v[8 * j + 2 * e + 1] = bf_hi(ww[e]); s += v[8 * j + 2 * e] + v[8 * j + 2 * e + 1]; } }
        const float mean = wave_sum(s) * (1.0f / 2048.0f); float q = 0.f;
#pragma unroll
        for (int e = 0; e < 32; ++e) { v[e] -= mean; q += v[e] * v[e]; }
        const float rstd = rsqrtf(wave_sum(q) * (1.0f / 2048.0f) + EPS);
#pragma unroll
        for (int j = 0; j < 4; ++j) { const int c0 = 8 * lane + 512 * j; unsigned o[4];
            const f32x4 g0 = *(const GAS f32x4*)(lg + c0), g1 = *(const GAS f32x4*)(lg + c0 + 4), b0 = *(const GAS f32x4*)(lb + c0), b1 = *(const GAS f32x4*)(lb + c0 + 4);
            o[0] = pk2(v[8 * j + 0] * rstd * g0[0] + b0[0], v[8 * j + 1] * rstd * g0[1] + b0[1]); o[1] = pk2(v[8 * j + 2] * rstd * g0[2] + b0[2], v[8 * j + 3] * rstd * g0[3] + b0[3]);
            o[2] = pk2(v[8 * j + 4] * rstd * g1[0] + b1[0], v[8 * j + 5] * rstd * g1[1] + b1[1]); o[3] = pk2(v[8 * j + 6] * rstd * g1[2] + b1[2], v[8 * j + 7] * rstd * g1[3] + b1[3]);
            u32x4 ov; ov.x = o[0]; ov.y = o[1]; ov.z = o[2]; ov.w = o[3];
            *(GAS u32x4*)(VLN + (size_t)row * D + c0) = ov; }
    }
}
__device__ __forceinline__ void sgu_spatial_phase(Ctx& F) {
    unsigned char* const ws_ = F_WS(F);
    const bf16_t* Z2 = (const bf16_t*)(ws_ + WS_PROJ); const bf16_t* VLN = (const bf16_t*)(ws_ + WS_QR); bf16_t* O = (bf16_t*)(ws_ + WS_O);
    const bf16_t* WSB = (const bf16_t*)(ws_ + WS_SG_WS); const float* bs = inp(F, I_SBS);
    const int tid = F.tid, lane = F.lane, wave = F.wave, fr = lane & 15, fq = lane >> 4;
    LAS bf16_t* vt = (LAS bf16_t*)F.lds;
    for (int u = F.wg; u < 64 * 8; u += F.G) {
        const int g = u & 7, c = u >> 3, row0 = c * 128;
        __syncthreads();
#pragma unroll 2
        for (int i = 0; i < 8; ++i) { const int id = tid + 512 * i, s = id >> 5, cc = id & 31;
            const u32x4 v = *(const GAS u32x4*)(VLN + (size_t)(row0 + s) * D + g * 256 + cc * 8); const unsigned w[4] = {v.x, v.y, v.z, v.w};
#pragma unroll
            for (int e = 0; e < 4; ++e) { vt[(8 * cc + 2 * e) * 136 + s] = (bf16_t)(w[e] & 0xffffu); vt[(8 * cc + 2 * e + 1) * 136 + s] = (bf16_t)(w[e] >> 16); } }
        __syncthreads();
        f32x4 acc[16];
#pragma unroll
        for (int nt = 0; nt < 16; ++nt) acc[nt] = (f32x4){0.f, 0.f, 0.f, 0.f};
#pragma unroll
        for (int ks = 0; ks < 4; ++ks) {
            const bf16x8 af = *(const GAS bf16x8*)(WSB + ((size_t)g * 128 + wave * 16 + fr) * 128 + ks * 32 + 8 * fq);
#pragma unroll
            for (int nt = 0; nt < 16; ++nt) { const bf16x8 bf = *(const LAS bf16x8*)(vt + (nt * 16 + fr) * 136 + ks * 32 + 8 * fq);
                acc[nt] = __builtin_amdgcn_mfma_f32_16x16x32_bf16(bf, af, acc[nt], 0, 0, 0); }
        }
        const int t = wave * 16 + fr; const float bias = bs[g * 128 + t];
        const bf16_t* urow = Z2 + (size_t)(row0 + t) * 4096 + g * 256 + 4 * fq; bf16_t* orow = O + (size_t)(row0 + t) * D + g * 256 + 4 * fq;
#pragma unroll
        for (int nt = 0; nt < 16; ++nt) { const u32x2 uv = *(const GAS u32x2*)(urow + nt * 16);
            u32x2 w; w.x = pk2(bf_lo(uv.x) * (acc[nt][0] + bias), bf_hi(uv.x) * (acc[nt][1] + bias)); w.y = pk2(bf_lo(uv.y) * (acc[nt][2] + bias), bf_hi(uv.y) * (acc[nt][3] + bias));
            *(GAS u32x2*)(orow + nt * 16) = w; }
    }
    __syncthreads();
}

struct Args { const float* in[26]; float* out; unsigned char* ws; int ph_lo, ph_hi; };
constexpr int N_PHASES = 2 + 11 + 8 + 9 + 11;

__global__ void __launch_bounds__(512, 2) mk_fwd(Args args) {
    extern __shared__ __attribute__((aligned(16))) unsigned char lds_raw[];
    Ctx F;
    F.lds = (LAS unsigned char*)lds_raw;
    const int wave0 = __builtin_amdgcn_readfirstlane((int)threadIdx.x >> 6);
    F.lane = (int)__builtin_amdgcn_mbcnt_hi(~0u, __builtin_amdgcn_mbcnt_lo(~0u, 0u)); F.wave = wave0; F.tid = wave0 * 64 + F.lane;
    F.G = gridDim.x; F.wg = blockIdx.x;
    volatile LAS unsigned* MISC = (volatile LAS unsigned*)(F.lds + MISC_OFF);
    for (int u = F.tid; u < (LDS_BYTES - LDSCTL_OFF) / 4; u += 512) ((LAS unsigned*)(F.lds + LDSCTL_OFF))[u] = 0u;
    __syncthreads();
    if (F.tid == 0) {
#pragma unroll
        for (int i = 0; i < 26; ++i) *(LAS unsigned long long*)(F.lds + PTR_OFF + 8 * i) = (unsigned long long)args.in[i];
        *(LAS unsigned long long*)(F.lds + PTR_OFF + 8 * 26) = (unsigned long long)args.out;
        *(LAS unsigned long long*)(F.lds + PTR_OFF + 8 * 27) = (unsigned long long)args.ws;
    }
    __syncthreads();
    const int lo = args.ph_lo, hi = args.ph_hi;
    if (hi - lo > 1) { XcdBarrier b0 = xcd_barrier_post((unsigned*)(args.ws + WS_CTL) + CW_BAR, MISC + 8); if (F.tid == 0) MISC[10] = b0.x; }
    __syncthreads();
    int ph = 0;
#define GRID_BAR() do { XcdBarrier b_; b_.bar = (unsigned*)(F_WS(F) + WS_CTL) + CW_BAR; b_.x = (unsigned)__builtin_amdgcn_readfirstlane((int)MISC[10]); b_.st = MISC + 8; xcd_barrier(b_); } while (0)
#define PH_BEGIN(b) if (EN(b) && ph >= lo && ph < hi) { { unsigned m_ = ~0u; asm volatile("" : "+s"(m_)); int l_ = (int)__builtin_amdgcn_mbcnt_hi(m_, __builtin_amdgcn_mbcnt_lo(m_, 0u)); asm volatile("" : "+v"(l_)); F.lane = l_; F.wave = wave0; F.tid = wave0 * 64 + l_; int g_ = (int)gridDim.x, w_ = (int)blockIdx.x; asm volatile("" : "+s"(g_), "+s"(w_)); F.G = g_; F.wg = w_; } unsigned char* const ws_ = F_WS(F); (void)ws_; {
#define PH_END   } if (ph + 1 < hi) GRID_BAR(); } ++ph;
#define P_RS   ((float*)(ws_ + WS_HN))
#define P_SSM  ((float*)(ws_ + WS_HN + MiB))
#define P_CTLW ((unsigned*)(ws_ + WS_CTL))
#define RSL_SETUP(S_) LAS float* rsl = (LAS float*)(F.lds + EPI_RED_OFF); int pm0 = -1; f32x4 ra = {0.f, 0.f, 0.f, 0.f}, rb = {0.f, 0.f, 0.f, 0.f}; \
    { pg8::Unit u0_; if ((S_).next(0, u0_)) { pm0 = u0_.pm; if (F.tid < 256) { const float* p_ = P_RS + (size_t)(pm0 * 256 + F.tid) * 8; ra = *(const GAS f32x4*)p_; rb = *(const GAS f32x4*)(p_ + 4); } } }
#define EPI_NORM(fz_, g_, alpha_, hq8_) pg8::EpiNorm<false>{P_HB, (g_), (alpha_), P_SSM, P_RS, P_CTLW + CW_NORM + (fz_) * 512, P_CTLW + CW_BAR, nullptr, (hq8_), (LAS float*)(F.lds + EPI_RED_OFF), F.tid, nullptr, nullptr}
#define P_ACT  ((bf16_t*)(ws_ + WS_ACT))
#define P_MB   ((bf16_t*)(ws_ + WS_MB))
#define P_HB   ((bf16_t*)(ws_ + WS_HB))
#define P_OB   ((bf16_t*)(ws_ + WS_O))
#define P_PROJ ((bf16_t*)(ws_ + WS_PROJ))
#define P_GATE ((bf16_t*)(ws_ + WS_GATE))
#define P_HQ8  ((unsigned char*)(ws_ + WS_GATE))
#define P_LW   (ws_ + WS_LW + (size_t)L * LW_SIZE)
#define P_G    (inp(F, I_NG) + (size_t)L * 8 * D)

    PH_BEGIN(0)
        p0_prologue(F);
        norm_phase(F, nullptr, nullptr, inp(F, I_X), 0.f, nullptr, P_HB, P_RS, nullptr, GU_F8(0) ? P_HQ8 : nullptr);
    PH_END
    PH_BEGIN(15)
        for (int L = 0; L < DEPTH; ++L) {
            pg8::Gemm gm{(const bf16_t*)(ws_ + WS_PB) + (size_t)L * M * PLE, (const bf16_t*)(P_LW + LW_PP), M, D, PLE}; pg8::StaticOrder S; S.init(M, D, F.G, F.wg);
            pg8::EpiBf16<0> E{(bf16_t*)(ws_ + WS_PE) + (size_t)L * M * D, D, nullptr};
            pg8::gemm_phase<pg8::EpiBf16<0>, pg8::StaticOrder, true, true>(F.lds, gm, S, E, F.tid);
        }
    PH_END

    for (int hs = 0; hs < 2 * DEPTH; ++hs) {
        const int L = hs >> 1, second = hs & 1;
        {
            const bool gu8 = GU_F8(hs) != 0u, d8 = D_F8(hs) != 0u;
            PH_BEGIN(1)
                pg8::Gemm gm{gu8 ? (const bf16_t*)P_HQ8 : (const bf16_t*)P_HB, (const bf16_t*)(P_LW + (second ? LW_GU2 : LW_GU1)), M, 2 * FF, D}; pg8::StaticOrder S; S.init(M, 2 * FF, F.G, F.wg);
                RSL_SETUP(S)
                if (gu8) {
                    if (d8) { if constexpr (ffn_combo_used(1, 1)) { pg8::EpiSwiglu<true> E{(void*)P_ACT, FF, P_RS, rsl, pm0, ra, rb}; pg8::gemm_phase<pg8::EpiSwiglu<true>, pg8::StaticOrder, true, true, true>(F.lds, gm, S, E, F.tid); } }
                    else { if constexpr (ffn_combo_used(1, 0)) { pg8::EpiSwiglu<false> E{(void*)P_ACT, FF, P_RS, rsl, pm0, ra, rb}; pg8::gemm_phase<pg8::EpiSwiglu<false>, pg8::StaticOrder, true, true, true>(F.lds, gm, S, E, F.tid); } }
                } else {
                    if (d8) { if constexpr (ffn_combo_used(0, 1)) { pg8::EpiSwiglu<true> E{(void*)P_ACT, FF, P_RS, rsl, pm0, ra, rb}; pg8::gemm_phase<pg8::EpiSwiglu<true>, pg8::StaticOrder, true, true, false>(F.lds, gm, S, E, F.tid); } }
                    else { if constexpr (ffn_combo_used(0, 0)) { pg8::EpiSwiglu<false> E{(void*)P_ACT, FF, P_RS, rsl, pm0, ra, rb}; pg8::gemm_phase<pg8::EpiSwiglu<false>, pg8::StaticOrder, true, true, false>(F.lds, gm, S, E, F.tid); } }
                }
            PH_END
            PH_BEGIN(1)
                pg8::Gemm gm{P_ACT, (const bf16_t*)(P_LW + (second ? LW_D2 : LW_D1)), M, D, FF}; pg8::StaticOrder S; S.init(M, D, F.G, F.wg);
                const pg8::EpiNorm<false> E = EPI_NORM(2 * hs, P_G + (second ? 5 : 1) * D, 0.5f, nullptr);
                if (d8) { if constexpr (ffn_d_used(1)) pg8::gemm_phase<pg8::EpiNorm<false>, pg8::StaticOrder, true, true, true>(F.lds, gm, S, E, F.tid); }
                else { if constexpr (ffn_d_used(0)) pg8::gemm_phase<pg8::EpiNorm<false>, pg8::StaticOrder, true, true, false>(F.lds, gm, S, E, F.tid); }
            PH_END
        }
        if (!second) {
            const int kind = L % 3, j = L / 3;
            if (kind == 0) {
                PH_BEGIN(3)
                    pg8::Gemm gm{P_HB, (const bf16_t*)(ws_ + WS_NSA + (size_t)j * NW_SIZE + NW_IN), M, NSA_NP, D}; pg8::StaticOrder S; S.init(M, NSA_NP, F.G, F.wg);
                    RSL_SETUP(S)
                    pg8::EpiBf16<0> E{P_PROJ, NSA_NP, P_RS, rsl, pm0, ra, rb};
                    pg8::gemm_phase<pg8::EpiBf16<0>, pg8::StaticOrder, true, true>(F.lds, gm, S, E, F.tid);
                PH_END
                PH_BEGIN(4) nsa_prep_phase(F); PH_END
                PH_BEGIN(5) nsa_cmp_hidden_phase(F, j); PH_END
                PH_BEGIN(6) nsa_cmp_out_phase(F, j); PH_END
                PH_BEGIN(7) att::phase(F); PH_END
            } else if (kind == 1) {
                PH_BEGIN(8)
                    pg8::Gemm gm{P_HB, (const bf16_t*)(ws_ + WS_CV_IN), M, 3 * D, D}; pg8::StaticOrder S; S.init(M, 3 * D, F.G, F.wg);
                    RSL_SETUP(S)
                    pg8::EpiConvIn E{P_PROJ, P_PROJ + (size_t)M * D, P_RS, rsl, pm0, ra, rb};
                    pg8::gemm_phase<pg8::EpiConvIn, pg8::StaticOrder, true, true>(F.lds, gm, S, E, F.tid);
                PH_END
                PH_BEGIN(9) conv_phase(F); PH_END
            } else {
                PH_BEGIN(10)
                    pg8::Gemm gm{P_HB, (const bf16_t*)(ws_ + WS_SG_IN), M, 2 * D, D}; pg8::StaticOrder S; S.init(M, 2 * D, F.G, F.wg);
                    RSL_SETUP(S)
                    pg8::EpiBf16<1> E{P_PROJ, 2 * D, P_RS, rsl, pm0, ra, rb};
                    pg8::gemm_phase<pg8::EpiBf16<1>, pg8::StaticOrder, true, true>(F.lds, gm, S, E, F.tid);
                PH_END
                PH_BEGIN(11) sgu_ln_phase(F); PH_END
                PH_BEGIN(12) sgu_spatial_phase(F); PH_END
            }
            PH_BEGIN(13)
                const bf16_t* wout = (const bf16_t*)(kind == 0 ? ws_ + WS_NSA + (size_t)j * NW_SIZE + NW_OUT : (kind == 1 ? ws_ + WS_CV_OUT : ws_ + WS_SG_OUT));
                pg8::Gemm gm{P_OB, wout, M, D, D}; pg8::StaticOrder S; S.init(M, D, F.G, F.wg);
                const pg8::EpiNorm<false> E = EPI_NORM(2 * hs + 1, P_G + 3 * D, 1.0f, GU_F8(hs + 1) ? P_HQ8 : nullptr);
                pg8::gemm_phase<pg8::EpiNorm<false>, pg8::StaticOrder, true, true>(F.lds, gm, S, E, F.tid);
            PH_END
        } else {
            PH_BEGIN(14)
                pg8::Gemm gm{P_HB, (const bf16_t*)(P_LW + LW_PG), M, D, D}; pg8::StaticOrder S; S.init(M, D, F.G, F.wg);
                const bool lastl = (L + 1 == DEPTH);
                const pg8::EpiNorm<true> E{P_HB, P_G + 7 * D, 1.0f, P_SSM, lastl ? nullptr : P_RS, P_CTLW + CW_NORM + (2 * hs + 1) * 512, P_CTLW + CW_BAR, lastl ? F_OUT(F) : nullptr,
                                           (!lastl && GU_F8(hs + 1)) ? P_HQ8 : nullptr, (LAS float*)(F.lds + EPI_RED_OFF), F.tid, (const bf16_t*)(ws_ + WS_PE) + (size_t)L * M * D, P_RS};
                pg8::gemm_phase<pg8::EpiNorm<true>, pg8::StaticOrder, true, true>(F.lds, gm, S, E, F.tid);
            PH_END
        }
    }
#undef PH_BEGIN
#undef PH_END
}

extern "C" void kernel_launch(void* const* d_in, const int* in_sizes, int n_in, void* d_out, int out_size, void* d_ws, size_t ws_size, hipStream_t stream) {
    static int grid = 0;
    if (grid == 0) {
        if (n_in != 26 || out_size != M * D || ws_size < WS_END) { fprintf(stderr, "kernel_launch: unexpected shapes (n_in %d out %d ws %zu)\n", n_in, out_size, ws_size); grid = -1; return; }
        int dev = 0, cus = 0, per_cu = 0;
        if (hipGetDevice(&dev) != hipSuccess || hipDeviceGetAttribute(&cus, hipDeviceAttributeMultiprocessorCount, dev) != hipSuccess) { grid = -1; return; }
        if (hipFuncSetAttribute((const void*)mk_fwd, hipFuncAttributeMaxDynamicSharedMemorySize, LDS_BYTES) != hipSuccess) { fprintf(stderr, "kernel_launch: hipFuncSetAttribute failed\n"); grid = -1; return; }
        if (hipOccupancyMaxActiveBlocksPerMultiprocessor(&per_cu, (const void*)mk_fwd, 512, LDS_BYTES) != hipSuccess || per_cu < 1) { fprintf(stderr, "kernel_launch: occupancy query reports %d\n", per_cu); }
        (void)hipGetLastError();
        if (cus < 256) { fprintf(stderr, "kernel_launch: the fused-norm epilogue needs >= 256 resident workgroups (device has %d CUs)\n", cus); grid = -1; return; }
        grid = cus;
    }
    if (grid < 0) return;
    if (hipMemsetAsync((char*)d_ws + WS_CTL, 0, CTL_ZERO_BYTES, stream) != hipSuccess) return;
    Args a{};
    for (int i = 0; i < 26; ++i) a.in[i] = (const float*)d_in[i];
    a.out = (float*)d_out; a.ws = (unsigned char*)d_ws;
#if MK_ONE_LAUNCH
    a.ph_lo = 0; a.ph_hi = N_PHASES;
    hipLaunchKernelGGL(mk_fwd, dim3(grid), dim3(512), LDS_BYTES, stream, a);
#else
    for (int p = 0; p < N_PHASES; ++p) { a.ph_lo = p; a.ph_hi = p + 1; hipLaunchKernelGGL(mk_fwd, dim3(grid), dim3(512), LDS_BYTES, stream, a); }
#endif
}
```

```cpp
#include <hip/hip_runtime.h>
#include <cstdio>
#include <cstdint>

#ifndef MK_ONE_LAUNCH
#define MK_ONE_LAUNCH 1
#endif
#ifndef FP8_GU_MASK
#define FP8_GU_MASK 0xFEu
#endif
#ifndef FP8_D_MASK
#define FP8_D_MASK 0xFEu
#endif
#define GU_F8(hs_) (((FP8_GU_MASK) >> (hs_)) & 1u)
#define D_F8(hs_)  (((FP8_D_MASK) >> (hs_)) & 1u)
constexpr bool ffn_combo_used(unsigned gu, unsigned d) { for (int hs = 0; hs < 8; ++hs) if (GU_F8(hs) == gu && D_F8(hs) == d) return true; return false; }
constexpr bool ffn_d_used(unsigned d) { for (int hs = 0; hs < 8; ++hs) if (D_F8(hs) == d) return true; return false; }
#ifndef MK_EN
#define MK_EN 0xFFFFFu
#endif
#define EN(b) ((MK_EN >> (b)) & 1u)

#define GAS __attribute__((address_space(1)))
#define LAS __attribute__((address_space(3)))
typedef unsigned short bf16_t;
typedef short bf16x8 __attribute__((ext_vector_type(8)));
typedef short s16x4 __attribute__((ext_vector_type(4)));
typedef float f32x4 __attribute__((ext_vector_type(4)));
typedef float f32x2 __attribute__((ext_vector_type(2)));
typedef unsigned u32x4 __attribute__((ext_vector_type(4)));
typedef unsigned u32x2 __attribute__((ext_vector_type(2)));

constexpr int D = 2048, BATCH = 2, SEQ = 4096, M = BATCH * SEQ, DEPTH = 4;
constexpr int FF = 5632, PLE = 256;
constexpr int NSA_N = 5168, NSA_NP = 5376;
constexpr int OFF_Q = 0, OFF_KC = 2048, OFF_VC = 2560, OFF_KS = 3072, OFF_VS = 3584, OFF_KW = 4096, OFF_VW = 4608, OFF_GATE = 5120;
constexpr float EPS = 1e-6f;

namespace pg8 {
#define PG8_LAS __attribute__((address_space(3)))
constexpr int BM = 256, BK = 64, HALF = 128, HTB = HALF * BK * 2, STAGE_BYTES = 8 * HTB, NXCD = 8, WGM = 8;
__host__ __device__ __forceinline__ int lds_byte(int r, int c) { const int st = (r >> 4) * 2 + (c >> 5), rr = r & 15, cc = c & 31, ob = rr * 64 + cc * 2; return st * 1024 + (ob ^ (((ob >> 9) & 1) << 5)); }
__host__ __device__ __forceinline__ void stage_rc(int b, int& R, int& C) { const int st = b / 1024, sb = b % 1024, swz = sb ^ (((sb >> 9) & 1) << 5); R = (st >> 1) * 16 + swz / 64; C = (st & 1) * 32 + (swz % 64) / 2; }
__host__ __device__ __forceinline__ int perm32(int rho) { const int n = rho >> 4, i = rho & 15; return 8 * (i >> 2) + 4 * n + (i & 3); }
constexpr int F8_SCALE_B = 0x79797979, F8_SCALE_A = 0x7C7C7C7C;
struct Unit { int pm, pn; };
struct Gemm { const bf16_t* A; const bf16_t* Bt; int M, N, K; };
struct StaticOrder {
    int nM, nN, nwg, G, c;
    __host__ __device__ void init(int M_, int N_, int G_, int c_) { nM = M_ / BM; nN = N_ / BM; nwg = nM * nN; G = G_; c = c_; }
    __host__ __device__ __forceinline__ bool next(int i, Unit& u) const {
        const long L = (long)i * G + c; if (L >= nwg) return false;
        int wgid = (int)L; { const int q = nwg / NXCD, r = nwg % NXCD, xcd = wgid % NXCD, off = wgid / NXCD; wgid = (xcd < r ? xcd * (q + 1) : r * (q + 1) + (xcd - r) * q) + off; }
        const int nig = WGM * nN, gid = wgid / nig, fm = gid * WGM, gsz = (nM - fm) < WGM ? (nM - fm) : WGM;
        u.pm = fm + ((wgid % nig) % gsz); u.pn = (wgid % nig) / gsz; return true;
    }
    __device__ __forceinline__ void a_ready(const Unit&) const {}
    __device__ __forceinline__ void done(const Unit&) const {}
};
typedef __bf16 bf16x2_hw __attribute__((ext_vector_type(2)));
__device__ __forceinline__ unsigned cvt_pk_bf16(float lo, float hi) { const f32x2 v = {lo, hi}; return __builtin_bit_cast(unsigned, __builtin_convertvector(v, bf16x2_hw)); }

typedef int v8i32 __attribute__((ext_vector_type(8)));
typedef int v4i32 __attribute__((ext_vector_type(4)));
template <class Epi, class Sched, bool ALIGN_EPI = false, bool SP2 = false, bool F8 = false>
__device__ __forceinline__ void gemm_phase(PG8_LAS unsigned char* lds, const Gemm g, const Sched& S, const Epi& E, int tid) {
    asm volatile("" : "+v"(tid));
    const int wid = __builtin_amdgcn_readfirstlane(tid >> 6), lane = tid & 63, wr = wid >> 2, wc = wid & 3, fr = lane & 15, fq = lane >> 4;
    const int K = g.K, nt = F8 ? K / 128 : K / BK; const int Kb = F8 ? K : 2 * K;
    unsigned voffA[2], voffB[2];
#pragma unroll
    for (int i = 0; i < 2; ++i) { int R, C; stage_rc(tid * 16 + i * 8192, R, C); const int Rb = Epi::PERM ? ((R & ~31) + perm32(R & 31)) : R;
        voffA[i] = (unsigned)(R * Kb + C * 2); voffB[i] = (unsigned)(Rb * Kb + C * 2); }
    const size_t kstep = (size_t)(BK * 2);
    const size_t hstep = (size_t)HALF * Kb;
    const size_t tstep = 2 * hstep;
    const unsigned ldsw = (unsigned)wid * 1024u;
    const int aoff = lds_byte(wr * 64 + fr, fq * 8), boff = lds_byte(wc * 32 + fr, fq * 8);
#define PG8_SA(b, h) (((b) * 2 + (h)) * HTB)
#define PG8_SB(b, h) ((4 + (b) * 2 + (h)) * HTB)
#define PG8_STAGE(bufoff, gbase, voff) do { _Pragma("unroll") for (int _i = 0; _i < 2; ++_i) \
        __builtin_amdgcn_global_load_lds((const unsigned*)((const char*)(gbase) + (voff)[_i]), (PG8_LAS unsigned*)(lds + (bufoff) + ldsw + _i * 8192), 16, 0, 0); } while (0)
#define PG8_LD16(off) __builtin_bit_cast(v4i32, *(const PG8_LAS bf16x8*)(lds + off))
#define PG8_LDA(dst, b, h) do { if constexpr (F8) { _Pragma("unroll") for (int m = 0; m < 4; ++m) dst##8[m] = __builtin_shufflevector(PG8_LD16(PG8_SA(b, h) + aoff + m * 2048 + 0 * 1024), PG8_LD16(PG8_SA(b, h) + aoff + m * 2048 + 1 * 1024), 0, 1, 2, 3, 4, 5, 6, 7); } \
        else { _Pragma("unroll") for (int m = 0; m < 4; ++m) _Pragma("unroll") for (int k = 0; k < 2; ++k) dst[m][k] = *(const PG8_LAS bf16x8*)(lds + PG8_SA(b, h) + aoff + m * 2048 + k * 1024); } } while (0)
#define PG8_LDB(dst, b, h) do { if constexpr (F8) { _Pragma("unroll") for (int n = 0; n < 2; ++n) dst##8[n] = __builtin_shufflevector(PG8_LD16(PG8_SB(b, h) + boff + n * 2048 + 0 * 1024), PG8_LD16(PG8_SB(b, h) + boff + n * 2048 + 1 * 1024), 0, 1, 2, 3, 4, 5, 6, 7); } \
        else { _Pragma("unroll") for (int n = 0; n < 2; ++n) _Pragma("unroll") for (int k = 0; k < 2; ++k) dst[n][k] = *(const PG8_LAS bf16x8*)(lds + PG8_SB(b, h) + boff + n * 2048 + k * 1024); } } while (0)
#define PG8_CAT8(x0, x1) __builtin_shufflevector(__builtin_bit_cast(v4i32, x0), __builtin_bit_cast(v4i32, x1), 0, 1, 2, 3, 4, 5, 6, 7)
#define PG8_MMA(ai, bj, At, Bt) do { __builtin_amdgcn_s_setprio(1); _Pragma("unroll") for (int m = 0; m < 4; ++m) _Pragma("unroll") for (int n = 0; n < 2; ++n) { \
        if constexpr (F8) asm volatile("v_mfma_scale_f32_16x16x128_f8f6f4 %0, %1, %2, %0, %3, %4 op_sel_hi:[0,0,0]" : "+v"(acc[ai][bj][m][n]) : "v"(Bt##8[n]), "v"(At##8[m]), "v"(f8sb), "v"(f8sa)); \
        else { _Pragma("unroll") for (int k = 0; k < 2; ++k) acc[ai][bj][m][n] = __builtin_amdgcn_mfma_f32_16x16x32_bf16(Bt[n][k], At[m][k], acc[ai][bj][m][n], 0, 0, 0); } } \
        __builtin_amdgcn_s_setprio(0); } while (0)
#define PG8_WAIT_V(n) asm volatile("s_waitcnt vmcnt(" #n ")" ::: "memory")
#define PG8_WAIT_L(n) asm volatile("s_waitcnt lgkmcnt(" #n ")" ::: "memory")
#define PG8_BAR __builtin_amdgcn_s_barrier()
#define PG8_SCHED __builtin_amdgcn_sched_barrier(0)
    Unit cur, nxt; int ui = 0;
    if (!S.next(0, cur)) return;
    f32x4 acc[2][2][4][2];
#pragma unroll
    for (int a = 0; a < 2; ++a)
#pragma unroll
        for (int b = 0; b < 2; ++b)
#pragma unroll
            for (int m = 0; m < 4; ++m)
#pragma unroll
                for (int n = 0; n < 2; ++n) acc[a][b][m][n] = (f32x4){0.f, 0.f, 0.f, 0.f};
    bf16x8 At[4][2], B0[2][2], B1[2][2];
    v8i32 At8[4], B08[2], B18[2];
    int f8sb = F8_SCALE_B, f8sa = F8_SCALE_A; asm volatile("" : "+v"(f8sb), "+v"(f8sa));
    const char* cA = (const char*)g.A + (size_t)cur.pm * tstep; const char* cB = (const char*)g.Bt + (size_t)cur.pn * tstep;
    S.a_ready(cur);
    if constexpr (SP2) {
        PG8_STAGE(PG8_SB(0, 0), cB, voffB); PG8_STAGE(PG8_SB(0, 1), cB + hstep, voffB); PG8_STAGE(PG8_SA(0, 0), cA, voffA); PG8_STAGE(PG8_SA(0, 1), cA + hstep, voffA);
        if (wr == 1) PG8_BAR;
        PG8_WAIT_V(2); PG8_BAR;
        PG8_STAGE(PG8_SB(1, 0), cB + kstep, voffB); PG8_STAGE(PG8_SA(1, 0), cA + kstep, voffA); PG8_STAGE(PG8_SB(1, 1), cB + hstep + kstep, voffB);
        PG8_WAIT_V(6); PG8_BAR;
    } else {
        PG8_STAGE(PG8_SB(0, 0), cB, voffB); PG8_STAGE(PG8_SA(0, 0), cA, voffA); PG8_STAGE(PG8_SB(0, 1), cB + hstep, voffB); PG8_STAGE(PG8_SA(0, 1), cA + hstep, voffA);
        if (wr == 1) PG8_BAR;
        PG8_WAIT_V(4); PG8_BAR;
        PG8_STAGE(PG8_SB(1, 0), cB + kstep, voffB); PG8_STAGE(PG8_SA(1, 0), cA + kstep, voffA); PG8_STAGE(PG8_SB(1, 1), cB + hstep + kstep, voffB);
        PG8_WAIT_V(6); PG8_BAR;
    }
    for (;;) {
        const bool has_next = S.next(ui + 1, nxt);
        const char* nA = has_next ? (const char*)g.A + (size_t)nxt.pm * tstep : cA; const char* nB = has_next ? (const char*)g.Bt + (size_t)nxt.pn * tstep : cB;
#pragma nounroll
        for (int t = 0; t < nt; t += 2) {
            const bool last = (t == nt - 2);
            const char* a1 = cA + (size_t)(t + 1) * kstep;
            const char* a2 = last ? nA : cA + (size_t)(t + 2) * kstep; const char* b2 = last ? nB : cB + (size_t)(t + 2) * kstep;
            const char* a3 = a2 + kstep; const char* b3 = b2 + kstep;
            if (last && has_next) S.a_ready(nxt);
            if constexpr (SP2) {
            PG8_LDB(B0, 0, 0); PG8_LDB(B1, 0, 1); PG8_SCHED; PG8_LDA(At, 0, 0); PG8_STAGE(PG8_SA(1, 1), a1 + hstep, voffA);
            PG8_WAIT_V(8); PG8_WAIT_L(0); PG8_BAR; PG8_MMA(0, 0, At, B0); PG8_MMA(0, 1, At, B1); PG8_BAR; PG8_SCHED;
            PG8_LDA(At, 0, 1); PG8_STAGE(PG8_SB(0, 0), b2, voffB); PG8_STAGE(PG8_SB(0, 1), b2 + hstep, voffB); PG8_STAGE(PG8_SA(0, 0), a2, voffA);
            PG8_WAIT_V(8); PG8_WAIT_L(0); PG8_BAR; PG8_MMA(1, 0, At, B0); PG8_MMA(1, 1, At, B1); PG8_BAR; PG8_SCHED;
            PG8_LDB(B0, 1, 0); PG8_LDB(B1, 1, 1); PG8_SCHED; PG8_LDA(At, 1, 0); PG8_STAGE(PG8_SA(0, 1), a2 + hstep, voffA);
            PG8_WAIT_V(8); PG8_WAIT_L(0); PG8_BAR; PG8_MMA(0, 0, At, B0); PG8_MMA(0, 1, At, B1); PG8_BAR; PG8_SCHED;
            PG8_LDA(At, 1, 1); PG8_STAGE(PG8_SB(1, 0), b3, voffB); PG8_STAGE(PG8_SB(1, 1), b3 + hstep, voffB); PG8_STAGE(PG8_SA(1, 0), a3, voffA);
            PG8_WAIT_V(8); PG8_WAIT_L(0); PG8_BAR; PG8_MMA(1, 0, At, B0); PG8_MMA(1, 1, At, B1); PG8_BAR; PG8_SCHED;
            } else {
            PG8_LDB(B0, 0, 0); PG8_SCHED; PG8_LDA(At, 0, 0); PG8_STAGE(PG8_SA(1, 1), a1 + hstep, voffA);
            PG8_WAIT_L(8); PG8_BAR; PG8_WAIT_L(0); PG8_MMA(0, 0, At, B0); PG8_BAR; PG8_SCHED;
            PG8_LDB(B1, 0, 1); PG8_STAGE(PG8_SB(0, 0), b2, voffB);
            PG8_BAR; PG8_WAIT_L(0); PG8_MMA(0, 1, At, B1); PG8_BAR;
            PG8_LDA(At, 0, 1); PG8_STAGE(PG8_SA(0, 0), a2, voffA);
            PG8_BAR; PG8_WAIT_L(0); PG8_MMA(1, 0, At, B0); PG8_BAR; PG8_SCHED;
            PG8_STAGE(PG8_SB(0, 1), b2 + hstep, voffB);
            PG8_WAIT_V(6); PG8_BAR; PG8_MMA(1, 1, At, B1); PG8_BAR;
            PG8_LDB(B0, 1, 0); PG8_SCHED; PG8_LDA(At, 1, 0); PG8_STAGE(PG8_SA(0, 1), a2 + hstep, voffA);
            PG8_WAIT_L(8); PG8_BAR; PG8_WAIT_L(0); PG8_MMA(0, 0, At, B0); PG8_BAR; PG8_SCHED;
            PG8_LDB(B1, 1, 1); PG8_STAGE(PG8_SB(1, 0), b3, voffB);
            PG8_BAR; PG8_WAIT_L(0); PG8_MMA(0, 1, At, B1); PG8_BAR;
            PG8_LDA(At, 1, 1); PG8_STAGE(PG8_SA(1, 0), a3, voffA);
            PG8_BAR; PG8_WAIT_L(0); PG8_MMA(1, 0, At, B0); PG8_BAR; PG8_SCHED;
            PG8_STAGE(PG8_SB(1, 1), b3 + hstep, voffB);
            PG8_WAIT_V(6); PG8_BAR; PG8_MMA(1, 1, At, B1); PG8_BAR;
            }
        }
        if constexpr (ALIGN_EPI) { if (wr == 0) PG8_BAR; }
        if constexpr (F8) asm volatile("s_nop 15\n\ts_nop 3" ::: "memory");
        E(acc, cur, wr, wc, fr, fq); S.done(cur);
        if (!has_next) break;
#pragma unroll
        for (int a = 0; a < 2; ++a)
#pragma unroll
            for (int b = 0; b < 2; ++b)
#pragma unroll
                for (int m = 0; m < 4; ++m)
#pragma unroll
                    for (int n = 0; n < 2; ++n) acc[a][b][m][n] = (f32x4){0.f, 0.f, 0.f, 0.f};
        cur = nxt; cA = nA; cB = nB; ++ui;
        if constexpr (ALIGN_EPI) { if (wr == 1) PG8_BAR; }
    }
    PG8_WAIT_V(0);
    if constexpr (!ALIGN_EPI) { if (wr == 0) PG8_BAR; }
    PG8_BAR;
#undef PG8_SA
#undef PG8_SB
#undef PG8_STAGE
#undef PG8_LDA
#undef PG8_LD16
#undef PG8_LDB
#undef PG8_MMA
#undef PG8_CAT8
#undef PG8_WAIT_V
#undef PG8_WAIT_L
#undef PG8_BAR
#undef PG8_SCHED
}

__device__ __forceinline__ float fast_sigmoid(float x) { return __builtin_amdgcn_rcpf(1.0f + __builtin_amdgcn_exp2f(-1.44269504f * x)); }
__device__ __forceinline__ float silu_f(float x) { return x * fast_sigmoid(x); }
__device__ __forceinline__ float gelu_tanh_f(float x) { const float y = 0.7978845608f * (x + 0.044715f * x * x * x); return x * fast_sigmoid(2.0f * y); }

__device__ __forceinline__ float row_rs(const float* ss, int row) {
    const f32x4 a = *(const f32x4*)(ss + (size_t)row * 8), b = *(const f32x4*)(ss + (size_t)row * 8 + 4);
    return __builtin_amdgcn_rsqf((((a[0] + a[1]) + (a[2] + a[3])) + ((b[0] + b[1]) + (b[2] + b[3]))) * (1.0f / 2048.0f) + 1e-6f);
}
struct EpiF32 {
    static constexpr bool PERM = false;
    float* C; int ldc;
    __device__ __forceinline__ void operator()(const f32x4 (&acc)[2][2][4][2], const Unit& u, int wr, int wc, int fr, int fq) const {
        const int row0 = u.pm * BM + wr * 64 + fr, col0 = u.pn * BM + wc * 32 + 4 * fq;
#pragma unroll
        for (int ai = 0; ai < 2; ++ai)
#pragma unroll
            for (int m = 0; m < 4; ++m) { float* rowp = C + (size_t)(row0 + ai * HALF + m * 16) * ldc + col0;
#pragma unroll
                for (int bj = 0; bj < 2; ++bj)
#pragma unroll
                    for (int n = 0; n < 2; ++n) *(f32x4*)(rowp + bj * HALF + n * 16) = acc[ai][bj][m][n]; }
    }
};
struct EpiGateMul {
    static constexpr bool PERM = true;
    bf16_t* C; const bf16_t* G; int ldc;
    __device__ __forceinline__ void operator()(const f32x4 (&acc)[2][2][4][2], const Unit& u, int wr, int wc, int fr, int fq) const {
        const int row0 = u.pm * BM + wr * 64 + fr, col0 = u.pn * BM + wc * 32 + 8 * fq;
#pragma unroll
        for (int ai = 0; ai < 2; ++ai)
#pragma unroll
            for (int m = 0; m < 4; ++m) { const size_t off = (size_t)(row0 + ai * HALF + m * 16) * ldc + col0;
#pragma unroll
                for (int bj = 0; bj < 2; ++bj) { const u32x4 gv = *(const u32x4*)(G + off + bj * HALF);
                    const f32x4 v0 = acc[ai][bj][m][0], v1 = acc[ai][bj][m][1];
                    u32x4 w; w.x = cvt_pk_bf16(v0[0] * __uint_as_float(gv.x << 16), v0[1] * __uint_as_float(gv.x & 0xffff0000u)); w.y = cvt_pk_bf16(v0[2] * __uint_as_float(gv.y << 16), v0[3] * __uint_as_float(gv.y & 0xffff0000u));
                    w.z = cvt_pk_bf16(v1[0] * __uint_as_float(gv.z << 16), v1[1] * __uint_as_float(gv.z & 0xffff0000u)); w.w = cvt_pk_bf16(v1[2] * __uint_as_float(gv.w << 16), v1[3] * __uint_as_float(gv.w & 0xffff0000u));
                    *(u32x4*)(C + off + bj * HALF) = w; asm volatile("" ::: "memory"); } }
    }
};
struct EpiSigMul {
    static constexpr bool PERM = true;
    bf16_t* C; const bf16_t* P; int ldc; const float* rs;
    __device__ __forceinline__ void operator()(const f32x4 (&acc)[2][2][4][2], const Unit& u, int wr, int wc, int fr, int fq) const {
        const int row0 = u.pm * BM + wr * 64 + fr, col0 = u.pn * BM + wc * 32 + 8 * fq;
#pragma unroll
        for (int ai = 0; ai < 2; ++ai)
#pragma unroll
            for (int m = 0; m < 4; ++m) { const size_t off = (size_t)(row0 + ai * HALF + m * 16) * ldc + col0; const float rsv = row_rs(rs, row0 + ai * HALF + m * 16);
#pragma unroll
                for (int bj = 0; bj < 2; ++bj) { const u32x4 pv = *(const u32x4*)(P + off + bj * HALF);
                    const f32x4 v0 = acc[ai][bj][m][0] * rsv, v1 = acc[ai][bj][m][1] * rsv;
                    u32x4 w; w.x = cvt_pk_bf16(fast_sigmoid(v0[0]) * __uint_as_float(pv.x << 16), fast_sigmoid(v0[1]) * __uint_as_float(pv.x & 0xffff0000u));
                    w.y = cvt_pk_bf16(fast_sigmoid(v0[2]) * __uint_as_float(pv.y << 16), fast_sigmoid(v0[3]) * __uint_as_float(pv.y & 0xffff0000u));
                    w.z = cvt_pk_bf16(fast_sigmoid(v1[0]) * __uint_as_float(pv.z << 16), fast_sigmoid(v1[1]) * __uint_as_float(pv.z & 0xffff0000u));
                    w.w = cvt_pk_bf16(fast_sigmoid(v1[2]) * __uint_as_float(pv.w << 16), fast_sigmoid(v1[3]) * __uint_as_float(pv.w & 0xffff0000u));
                    *(u32x4*)(C + off + bj * HALF) = w; asm volatile("" ::: "memory"); } }
    }
};
template <int ACT> struct EpiBf16 {
    static constexpr bool PERM = true;
    bf16_t* O; int ldc; const float* rs;
    PG8_LAS const float* rsl = nullptr; int pm0 = -1;
    __device__ __forceinline__ void operator()(const f32x4 (&acc)[2][2][4][2], const Unit& u, int wr, int wc, int fr, int fq) const {
        const int row0 = u.pm * BM + wr * 64 + fr, col0 = u.pn * BM + wc * 32 + 8 * fq;
        const bool cached = (u.pm == pm0);
#pragma unroll
        for (int ai = 0; ai < 2; ++ai)
#pragma unroll
            for (int m = 0; m < 4; ++m) { bf16_t* rowp = O + (size_t)(row0 + ai * HALF + m * 16) * ldc + col0;
                const float rsv = rs ? (cached ? rsl[wr * 64 + fr + ai * HALF + m * 16] : row_rs(rs, row0 + ai * HALF + m * 16)) : 1.0f;
#pragma unroll
                for (int bj = 0; bj < 2; ++bj) { f32x4 v0 = acc[ai][bj][m][0] * rsv, v1 = acc[ai][bj][m][1] * rsv;
                    if (ACT == 1) {
#pragma unroll
                        for (int j = 0; j < 4; ++j) { v0[j] = gelu_tanh_f(v0[j]); v1[j] = gelu_tanh_f(v1[j]); } }
                    if (ACT == 2) {
#pragma unroll
                        for (int j = 0; j < 4; ++j) { v0[j] = fast_sigmoid(v0[j]); v1[j] = fast_sigmoid(v1[j]); } }
                    u32x4 w; w.x = cvt_pk_bf16(v0[0], v0[1]); w.y = cvt_pk_bf16(v0[2], v0[3]); w.z = cvt_pk_bf16(v1[0], v1[1]); w.w = cvt_pk_bf16(v1[2], v1[3]);
                    *(u32x4*)(rowp + bj * HALF) = w; } }
    }
};
template <bool F8OUT> struct EpiSwiglu {
    static constexpr bool PERM = true;
    void* O; int ldc; const float* rs;
    PG8_LAS const float* rsl; int pm0;
    __device__ __forceinline__ void operator()(const f32x4 (&acc)[2][2][4][2], const Unit& u, int wr, int wc, int fr, int fq) const {
        const int row0 = u.pm * BM + wr * 64 + fr, col0 = u.pn * HALF + wc * 32 + 8 * fq;
        float rsr[2][4];
        if (u.pm == pm0) {
#pragma unroll
            for (int ai = 0; ai < 2; ++ai)
#pragma unroll
                for (int m = 0; m < 4; ++m) rsr[ai][m] = rsl[wr * 64 + fr + ai * HALF + m * 16];
        } else {
#pragma unroll
            for (int ai = 0; ai < 2; ++ai)
#pragma unroll
                for (int m = 0; m < 4; ++m) rsr[ai][m] = row_rs(rs, row0 + ai * HALF + m * 16);
        }
#pragma unroll
        for (int ai = 0; ai < 2; ++ai)
#pragma unroll
            for (int m = 0; m < 4; ++m) { const size_t eoff = (size_t)(row0 + ai * HALF + m * 16) * ldc + col0; const float rsv = rsr[ai][m];
                const float cexp = rsv * -1.44269504f, sc = rsv * rsv * (F8OUT ? 8.0f : 1.0f);
                f32x4 e0 = acc[ai][0][m][0] * cexp, e1 = acc[ai][0][m][1] * cexp, t0 = acc[ai][0][m][0] * acc[ai][1][m][0], t1 = acc[ai][0][m][1] * acc[ai][1][m][1];
                __builtin_amdgcn_sched_barrier(0);
#pragma unroll
                for (int j = 0; j < 4; ++j) { e0[j] = __builtin_amdgcn_exp2f(e0[j]); e1[j] = __builtin_amdgcn_exp2f(e1[j]); }
                __builtin_amdgcn_sched_barrier(0);
                e0 = e0 + 1.0f; e1 = e1 + 1.0f; t0 = t0 * sc; t1 = t1 * sc;
                __builtin_amdgcn_sched_barrier(0);
#pragma unroll
                for (int j = 0; j < 4; ++j) { e0[j] = __builtin_amdgcn_rcpf(e0[j]); e1[j] = __builtin_amdgcn_rcpf(e1[j]); }
                __builtin_amdgcn_sched_barrier(0);
                f32x4 v0 = t0 * e0, v1 = t1 * e1;
                if constexpr (F8OUT) {
                    int w0 = 0, w1 = 0;
#pragma unroll
                    for (int j = 0; j < 4; ++j) { v0[j] = __builtin_amdgcn_fmed3f(v0[j], -448.0f, 448.0f); v1[j] = __builtin_amdgcn_fmed3f(v1[j], -448.0f, 448.0f); }
                    w0 = __builtin_amdgcn_cvt_pk_fp8_f32(v0[0], v0[1], w0, false); w0 = __builtin_amdgcn_cvt_pk_fp8_f32(v0[2], v0[3], w0, true);
                    w1 = __builtin_amdgcn_cvt_pk_fp8_f32(v1[0], v1[1], w1, false); w1 = __builtin_amdgcn_cvt_pk_fp8_f32(v1[2], v1[3], w1, true);
                    u32x2 w; w.x = (unsigned)w0; w.y = (unsigned)w1; *(u32x2*)((unsigned char*)O + eoff) = w;
                } else {
                    u32x4 w; w.x = cvt_pk_bf16(v0[0], v0[1]); w.y = cvt_pk_bf16(v0[2], v0[3]); w.z = cvt_pk_bf16(v1[0], v1[1]); w.w = cvt_pk_bf16(v1[2], v1[3]);
                    *(u32x4*)((bf16_t*)O + eoff) = w;
                }
                __builtin_amdgcn_sched_barrier(0);
            }
    }
};
struct EpiConvIn {
    static constexpr bool PERM = true;
    bf16_t* BG; bf16_t* Z; const float* rs;
    PG8_LAS const float* rsl = nullptr; int pm0 = -1;
    __device__ __forceinline__ float rsget(const Unit& u, int lrow, int row) const { return (u.pm == pm0) ? rsl[lrow] : row_rs(rs, row); }
    __device__ __forceinline__ void operator()(const f32x4 (&acc)[2][2][4][2], const Unit& u, int wr, int wc, int fr, int fq) const {
        const int row0 = u.pm * BM + wr * 64 + fr;
        if (u.pn < 8) {
            const int col0 = u.pn * BM + wc * 32 + 8 * fq;
#pragma unroll
            for (int ai = 0; ai < 2; ++ai)
#pragma unroll
                for (int m = 0; m < 4; ++m) { bf16_t* rowp = BG + (size_t)(row0 + ai * HALF + m * 16) * D + col0; const float rsv = rsget(u, wr * 64 + fr + ai * HALF + m * 16, row0 + ai * HALF + m * 16);
#pragma unroll
                    for (int bj = 0; bj < 2; ++bj) { const f32x4 v0 = acc[ai][bj][m][0] * rsv, v1 = acc[ai][bj][m][1] * rsv;
                        u32x4 w; w.x = cvt_pk_bf16(v0[0], v0[1]); w.y = cvt_pk_bf16(v0[2], v0[3]); w.z = cvt_pk_bf16(v1[0], v1[1]); w.w = cvt_pk_bf16(v1[2], v1[3]);
                        *(u32x4*)(rowp + bj * HALF) = w; } }
        } else {
            const int col0 = (u.pn - 8) * HALF + wc * 32 + 8 * fq;
#pragma unroll
            for (int ai = 0; ai < 2; ++ai)
#pragma unroll
                for (int m = 0; m < 4; ++m) { bf16_t* rowp = Z + (size_t)(row0 + ai * HALF + m * 16) * D + col0; const float rsv = rsget(u, wr * 64 + fr + ai * HALF + m * 16, row0 + ai * HALF + m * 16), rs2 = rsv * rsv;
                    const f32x4 v0 = acc[ai][0][m][0] * acc[ai][1][m][0] * rs2, v1 = acc[ai][0][m][1] * acc[ai][1][m][1] * rs2;
                    u32x4 w; w.x = cvt_pk_bf16(v0[0], v0[1]); w.y = cvt_pk_bf16(v0[2], v0[3]); w.z = cvt_pk_bf16(v1[0], v1[1]); w.w = cvt_pk_bf16(v1[2], v1[3]);
                    *(u32x4*)rowp = w; }
        }
    }
};
}

constexpr size_t MiB = 1u << 20;
constexpr size_t WS_CTL = 0, CTL_ZERO_BYTES = 1 * MiB;
constexpr size_t LW_GU1 = 0, LW_D1 = 44 * MiB, LW_GU2 = 66 * MiB, LW_D2 = 110 * MiB, LW_PG = 132 * MiB, LW_PP = 140 * MiB, LW_SIZE = 141 * MiB;
constexpr size_t WS_LW = 1 * MiB;
constexpr size_t NW_IN = 0, NW_OUT = 21 * MiB, NW_W1 = 29 * MiB, NW_W2 = 33 * MiB, NW_BP = 33 * MiB + 512 * 1024, NW_SIZE = 34 * MiB;
constexpr size_t WS_NSA = 565 * MiB;
constexpr size_t WS_CV_IN = 633 * MiB, WS_CV_OUT = 657 * MiB;
constexpr size_t WS_SG_IN = 665 * MiB, WS_SG_OUT = 681 * MiB, WS_SG_WS = 689 * MiB;
constexpr size_t WS_HN = 690 * MiB;
constexpr size_t WS_ACT = 722 * MiB;
constexpr size_t WS_MB = 810 * MiB;
constexpr size_t WS_PROJ = 874 * MiB;
constexpr size_t WS_QR = 958 * MiB;
constexpr size_t WS_KSR = 990 * MiB, WS_KWR = 998 * MiB, WS_VST = 1006 * MiB, WS_VWT = 1014 * MiB;
constexpr size_t WS_HID = 1022 * MiB;
constexpr size_t WS_KC = 1024 * MiB, WS_VCT = 1024 * MiB + 512 * 1024;
constexpr size_t WS_O = 1025 * MiB;
constexpr size_t WS_PB = 1057 * MiB;
constexpr size_t WS_ROPE = 1073 * MiB;
constexpr size_t WS_GATE = 1074 * MiB;
constexpr size_t WS_HB = 1106 * MiB;
constexpr size_t WS_PE = 1138 * MiB;
constexpr size_t WS_END = 1266 * MiB;

constexpr int CW_TMO = 0, CW_BAR = 4096;

constexpr int RING_BYTES = 131072;
constexpr int LDSCTL_OFF = RING_BYTES, MISC_OFF = LDSCTL_OFF + 320;
constexpr int LDS_BYTES = 147456;

#define XB_TMO      128
#define XB_XCNT(j)  (256  + 64 * (j))
#define XB_XSUB(j)  (1280 + 64 * (j))
#define XB_XGEN(j)  (2304 + 64 * (j))
#define XB_TOP      3328
#define XB_TOPGEN   3392
#define XCD_BAR_WORDS 3456
#define XB_SPIN_CAP (1u << 18)
__device__ __forceinline__ unsigned xb_ld(unsigned* p)              { return __hip_atomic_load(p, __ATOMIC_RELAXED, __HIP_MEMORY_SCOPE_AGENT); }
__device__ __forceinline__ unsigned xb_add(unsigned* p, unsigned v) { return __hip_atomic_fetch_add(p, v, __ATOMIC_RELAXED, __HIP_MEMORY_SCOPE_AGENT); }
__device__ __forceinline__ unsigned xb_xcc_id() { return (unsigned)__builtin_amdgcn_s_getreg((3 << 11) | 20) & 0xFu; }
#define XB_SPIN(cond, bar) do { unsigned _sp = 0; while (cond) { __builtin_amdgcn_s_sleep(1); \
    if ((++_sp & 255u) == 0u) { if (xb_ld(&(bar)[XB_TMO])) break; if (_sp > XB_SPIN_CAP) { atomicAdd(&(bar)[XB_TMO], 1u); break; } } } } while (0)
struct XcdBarrier { unsigned* bar; unsigned x; volatile LAS unsigned* st; };
__device__ __forceinline__ XcdBarrier xcd_barrier_post(unsigned* bar, volatile LAS unsigned* st) {
    XcdBarrier b; b.bar = bar; b.x = xb_xcc_id(); b.st = st;
    if (threadIdx.x == 0) (void)xb_add(&bar[XB_XCNT(b.x)], 1u);
    return b;
}
__device__ __forceinline__ void xcd_barrier_complete(unsigned* bar, unsigned x, unsigned& nloc, unsigned& nx) {
    const unsigned G = gridDim.x * gridDim.y * gridDim.z;
    unsigned sum, cnt, mine, sp = 0u;
    for (;;) {
        sum = 0u; cnt = 0u; mine = 0u;
#pragma unroll
        for (unsigned j = 0; j < 16; ++j) { const unsigned c = xb_ld(&bar[XB_XCNT(j)]); sum += c; cnt += (c > 0u) ? 1u : 0u; mine = (j == x) ? c : mine; }
        if (sum == G) break;
        __builtin_amdgcn_s_sleep(1);
        if ((++sp & 255u) == 0u) { if (xb_ld(&bar[XB_TMO])) break; if (sp > XB_SPIN_CAP) { atomicAdd(&bar[XB_TMO], 1u); break; } }
    }
    nloc = mine > 0u ? mine : 1u; nx = cnt > 0u ? cnt : 1u;
}
__device__ __forceinline__ void xcd_barrier(const XcdBarrier& b) {
    asm volatile("s_waitcnt vmcnt(0)" ::: "memory");
    __syncthreads();
    if (threadIdx.x == 0) {
        unsigned* bar = b.bar;
        __builtin_amdgcn_s_waitcnt(0);
        unsigned nloc = b.st[0], nx = b.st[1];
        if (nloc == 0u) { xcd_barrier_complete(bar, b.x, nloc, nx); b.st[0] = nloc; b.st[1] = nx; }
        const unsigned old = xb_add(&bar[XB_XSUB(b.x)], 1u);
        const unsigned gen = old / nloc;
        if (old + 1u == (gen + 1u) * nloc) {
            __builtin_amdgcn_fence(__ATOMIC_RELEASE, "agent");
            asm volatile("s_waitcnt vmcnt(0)" ::: "memory");
            const unsigned og = xb_add(&bar[XB_TOP], 1u);
            const unsigned tg = og / nx;
            if (og + 1u == (tg + 1u) * nx) xb_add(&bar[XB_TOPGEN], 1u);
            else XB_SPIN(xb_ld(&bar[XB_TOPGEN]) == tg, bar);
            __builtin_amdgcn_fence(__ATOMIC_ACQUIRE, "agent");
            xb_add(&bar[XB_XGEN(b.x)], 1u);
            asm volatile("s_waitcnt vmcnt(0)" ::: "memory");
        } else {
            XB_SPIN(xb_ld(&bar[XB_XGEN(b.x)]) == gen, bar);
            __builtin_amdgcn_fence(__ATOMIC_ACQUIRE, "agent");
            asm volatile("s_waitcnt vmcnt(0)" ::: "memory");
        }
    }
    __syncthreads();
}

constexpr int CW_NORM = 16384;
constexpr int EPI_RED_OFF = 131072 + 2048;
namespace pg8 {
#define EPI_BAR() do { asm volatile("s_waitcnt lgkmcnt(0)" ::: "memory"); __builtin_amdgcn_s_barrier(); asm volatile("" ::: "memory"); } while (0)
template <bool PLE> struct EpiNorm {
    static constexpr bool PERM = true;
    bf16_t* H; const float* gpost; float alpha;
    float* ssm; float* ssh; unsigned* cnt; unsigned* bar;
    float* fout; unsigned char* hq8;
    PG8_LAS float* red; int tid;
    const bf16_t* pe; const float* rs;
    __device__ __forceinline__ void operator()(const f32x4 (&acc)[2][2][4][2], const Unit& u, int wr, int wc, int fr, int fq) const {
        const int lrow0 = wr * 64 + fr, col0 = u.pn * BM + wc * 32 + 8 * fq;
        f32x4 g[2][2];
        if constexpr (!PLE) {
#pragma unroll
            for (int bj = 0; bj < 2; ++bj) { g[bj][0] = *(const f32x4*)(gpost + col0 + bj * HALF); g[bj][1] = *(const f32x4*)(gpost + col0 + bj * HALF + 4); }
        }
        u32x4 hw[2][4][2];
        u32x4 yp[2][4][2];
        if constexpr (!PLE) {
#pragma unroll
            for (int m = 0; m < 4; ++m)
#pragma unroll
                for (int bj = 0; bj < 2; ++bj) hw[0][m][bj] = *(const u32x4*)(H + (size_t)(u.pm * BM + lrow0 + 16 * m) * 2048 + col0 + bj * HALF);
        }
#pragma unroll
        for (int ai = 0; ai < 2; ++ai) {
            u32x4 pv[4][2]; float rsv[4];
            if constexpr (PLE) {
#pragma unroll
                for (int m = 0; m < 4; ++m) { const int row = u.pm * BM + ai * HALF + lrow0 + 16 * m; rsv[m] = row_rs(rs, row);
#pragma unroll
                    for (int bj = 0; bj < 2; ++bj) pv[m][bj] = *(const u32x4*)(pe + (size_t)row * 2048 + col0 + bj * HALF); }
            }
#pragma unroll
            for (int m = 0; m < 4; ++m) { float s = 0.f;
                if constexpr (PLE) {
#pragma unroll
                    for (int bj = 0; bj < 2; ++bj) { const u32x4 p = pv[m][bj];
                        const f32x4 p0 = {__uint_as_float(p.x << 16), __uint_as_float(p.x & 0xffff0000u), __uint_as_float(p.y << 16), __uint_as_float(p.y & 0xffff0000u)};
                        const f32x4 p1 = {__uint_as_float(p.z << 16), __uint_as_float(p.z & 0xffff0000u), __uint_as_float(p.w << 16), __uint_as_float(p.w & 0xffff0000u)};
                        f32x4 v0 = acc[ai][bj][m][0] * rsv[m], v1 = acc[ai][bj][m][1] * rsv[m];
                        v0 = (f32x4){fast_sigmoid(v0[0]), fast_sigmoid(v0[1]), fast_sigmoid(v0[2]), fast_sigmoid(v0[3])} * p0; v1 = (f32x4){fast_sigmoid(v1[0]), fast_sigmoid(v1[1]), fast_sigmoid(v1[2]), fast_sigmoid(v1[3])} * p1;
#pragma unroll
                        for (int e = 0; e < 4; ++e) s += v0[e] * v0[e] + v1[e] * v1[e];
                        u32x4 w; w.x = cvt_pk_bf16(v0[0], v0[1]); w.y = cvt_pk_bf16(v0[2], v0[3]); w.z = cvt_pk_bf16(v1[0], v1[1]); w.w = cvt_pk_bf16(v1[2], v1[3]); yp[ai][m][bj] = w; }
                } else {
#pragma unroll
                for (int bj = 0; bj < 2; ++bj)
#pragma unroll
                    for (int n = 0; n < 2; ++n)
#pragma unroll
                        for (int e = 0; e < 4; ++e) s += acc[ai][bj][m][n][e] * acc[ai][bj][m][n][e];
                }
                auto r = __builtin_amdgcn_permlane16_swap(__float_as_uint(s), __float_as_uint(s), false, false); s = __uint_as_float(r[0]) + __uint_as_float(r[1]);
                auto q = __builtin_amdgcn_permlane32_swap(__float_as_uint(s), __float_as_uint(s), false, false); s = __uint_as_float(q[0]) + __uint_as_float(q[1]);
                if (fq == 0) red[wc * 256 + ai * HALF + lrow0 + 16 * m] = s; }
        }
        EPI_BAR();
        if (tid < 256) { const float v = (red[tid] + red[256 + tid]) + (red[512 + tid] + red[768 + tid]);
            __hip_atomic_store(ssm + (size_t)(u.pm * BM + tid) * 8 + u.pn, v, __ATOMIC_RELAXED, __HIP_MEMORY_SCOPE_AGENT); }
        asm volatile("s_waitcnt vmcnt(0)" ::: "memory");
        EPI_BAR();
        if (tid == 0) { unsigned* c = cnt + u.pm * 16; (void)xb_add(c, 1u); XB_SPIN(xb_ld(c) < 8u, bar); }
        EPI_BAR();
        if (tid < 256) { const float* p = ssm + (size_t)(u.pm * BM + tid) * 8; float v[8];
#pragma unroll
            for (int j = 0; j < 8; ++j) v[j] = __hip_atomic_load(p + j, __ATOMIC_RELAXED, __HIP_MEMORY_SCOPE_AGENT);
            red[1024 + tid] = alpha * __builtin_amdgcn_rsqf((((v[0] + v[1]) + (v[2] + v[3])) + ((v[4] + v[5]) + (v[6] + v[7]))) * (1.0f / 2048.0f) + 1e-6f); }
        EPI_BAR();
        if constexpr (!PLE) {
#pragma unroll
            for (int m2 = 0; m2 < 4; ++m2)
#pragma unroll
                for (int bj = 0; bj < 2; ++bj) hw[1][m2][bj] = *(const u32x4*)(H + (size_t)(u.pm * BM + HALF + lrow0 + 16 * m2) * 2048 + col0 + bj * HALF);
        }
        if constexpr (PLE) {
#pragma unroll
            for (int bj = 0; bj < 2; ++bj) { g[bj][0] = *(const f32x4*)(gpost + col0 + bj * HALF); g[bj][1] = *(const f32x4*)(gpost + col0 + bj * HALF + 4); }
        }
#pragma unroll
        for (int ai = 0; ai < 2; ++ai)
#pragma unroll
            for (int m = 0; m < 4; ++m) { const int lrow = ai * HALF + lrow0 + 16 * m; const size_t off = (size_t)(u.pm * BM + lrow) * 2048 + col0; const float r = red[1024 + lrow]; float s2 = 0.f;
                if (PLE && m == 0) { const int a2 = ai;
#pragma unroll
                    for (int m2 = 0; m2 < 4; ++m2)
#pragma unroll
                        for (int bj = 0; bj < 2; ++bj) hw[a2][m2][bj] = *(const u32x4*)(H + (size_t)(u.pm * BM + a2 * HALF + lrow0 + 16 * m2) * 2048 + col0 + bj * HALF);
                }
#pragma unroll
                for (int bj = 0; bj < 2; ++bj) { const unsigned hh[4] = {hw[ai][m][bj].x, hw[ai][m][bj].y, hw[ai][m][bj].z, hw[ai][m][bj].w}; float hv[8];
#pragma unroll
                    for (int e = 0; e < 4; ++e) { hv[2 * e] = __uint_as_float(hh[e] << 16); hv[2 * e + 1] = __uint_as_float(hh[e] & 0xffff0000u); }
                    f32x4 v0, v1;
                    if constexpr (PLE) { const u32x4 y = yp[ai][m][bj];
                        v0 = (f32x4){__uint_as_float(y.x << 16), __uint_as_float(y.x & 0xffff0000u), __uint_as_float(y.y << 16), __uint_as_float(y.y & 0xffff0000u)};
                        v1 = (f32x4){__uint_as_float(y.z << 16), __uint_as_float(y.z & 0xffff0000u), __uint_as_float(y.w << 16), __uint_as_float(y.w & 0xffff0000u)}; }
                    else { v0 = acc[ai][bj][m][0]; v1 = acc[ai][bj][m][1]; }
#pragma unroll
                    for (int e = 0; e < 4; ++e) { hv[e] += v0[e] * r * g[bj][0][e]; hv[4 + e] += v1[e] * r * g[bj][1][e]; }
#pragma unroll
                    for (int e = 0; e < 8; ++e) s2 += hv[e] * hv[e];
                    if (fout) { *(f32x4*)(fout + off + bj * HALF) = (f32x4){hv[0], hv[1], hv[2], hv[3]}; *(f32x4*)(fout + off + bj * HALF + 4) = (f32x4){hv[4], hv[5], hv[6], hv[7]}; }
                    else { u32x4 o; o.x = cvt_pk_bf16(hv[0], hv[1]); o.y = cvt_pk_bf16(hv[2], hv[3]); o.z = cvt_pk_bf16(hv[4], hv[5]); o.w = cvt_pk_bf16(hv[6], hv[7]);
                        *(u32x4*)(H + off + bj * HALF) = o;
                        if (hq8) { float c[8];
#pragma unroll
                            for (int e = 0; e < 8; ++e) c[e] = fminf(fmaxf(hv[e] * 8.0f, -448.0f), 448.0f);
                            int w0 = 0, w1 = 0;
                            w0 = __builtin_amdgcn_cvt_pk_fp8_f32(c[0], c[1], w0, false); w0 = __builtin_amdgcn_cvt_pk_fp8_f32(c[2], c[3], w0, true);
                            w1 = __builtin_amdgcn_cvt_pk_fp8_f32(c[4], c[5], w1, false); w1 = __builtin_amdgcn_cvt_pk_fp8_f32(c[6], c[7], w1, true);
                            u32x2 w; w.x = (unsigned)w0; w.y = (unsigned)w1; *(u32x2*)(hq8 + off + bj * HALF) = w; } } }
                auto r1 = __builtin_amdgcn_permlane16_swap(__float_as_uint(s2), __float_as_uint(s2), false, false); s2 = __uint_as_float(r1[0]) + __uint_as_float(r1[1]);
                auto q1 = __builtin_amdgcn_permlane32_swap(__float_as_uint(s2), __float_as_uint(s2), false, false); s2 = __uint_as_float(q1[0]) + __uint_as_float(q1[1]);
                if (fq == 0) red[wc * 256 + lrow] = s2; }
        EPI_BAR();
        if (ssh && tid < 256) ssh[(size_t)(u.pm * BM + tid) * 8 + u.pn] = (red[tid] + red[256 + tid]) + (red[512 + tid] + red[768 + tid]);
    }
};
}

#define LDS_WAIT() asm volatile("s_waitcnt lgkmcnt(0)" ::: "memory")
__device__ __forceinline__ unsigned f2bf(float f) { unsigned u = __builtin_bit_cast(unsigned, f); return (u + 0x7fffu + ((u >> 16) & 1u)) >> 16; }
__device__ __forceinline__ unsigned pk2(float lo, float hi) { return pg8::cvt_pk_bf16(lo, hi); }
__device__ __forceinline__ float bf_lo(unsigned w) { return __uint_as_float(w << 16); }
__device__ __forceinline__ float bf_hi(unsigned w) { return __uint_as_float(w & 0xffff0000u); }
__device__ __forceinline__ float wave_sum(float v) {
    v += __uint_as_float(__builtin_amdgcn_update_dpp(0u, __float_as_uint(v), 0xB1, 0xF, 0xF, false));
    v += __uint_as_float(__builtin_amdgcn_update_dpp(0u, __float_as_uint(v), 0x4E, 0xF, 0xF, false));
    v += __uint_as_float(__builtin_amdgcn_update_dpp(0u, __float_as_uint(v), 0x141, 0xF, 0xF, false));
    v += __uint_as_float(__builtin_amdgcn_update_dpp(0u, __float_as_uint(v), 0x140, 0xF, 0xF, false));
    auto r = __builtin_amdgcn_permlane16_swap(__float_as_uint(v), __float_as_uint(v), false, false); v = __uint_as_float(r[0]) + __uint_as_float(r[1]);
    auto q = __builtin_amdgcn_permlane32_swap(__float_as_uint(v), __float_as_uint(v), false, false); return __uint_as_float(q[0]) + __uint_as_float(q[1]);
}

struct Ctx {
    LAS unsigned char* lds;
    int tid, lane, wave, G, wg;
};
constexpr int PTR_OFF = 131072 + 1024;
__device__ __forceinline__ const float* inp(const Ctx& F, int i) {
    const unsigned long long v = *(const LAS unsigned long long*)(F.lds + PTR_OFF + 8 * i);
    const unsigned lo = __builtin_amdgcn_readfirstlane((unsigned)v), hi = __builtin_amdgcn_readfirstlane((unsigned)(v >> 32));
    return (const float*)(((unsigned long long)hi << 32) | lo);
}
#define F_WS(F)  ((unsigned char*)inp(F, 27))
#define F_OUT(F) ((float*)inp(F, 26))
#define F_GW(F)  ((F).wg * 8 + (F).wave)
#define F_NGW(F) ((F).G * 8)
enum { I_X = 0, I_P, I_NG, I_F1G, I_F1U, I_F1D, I_F2G, I_F2U, I_F2D, I_PLG, I_PLP, I_NIN, I_NOUT, I_PE, I_PW1, I_PB1, I_PW2, I_CIN, I_CW, I_COUT, I_SIN, I_SLG, I_SLB, I_SWS, I_SBS, I_SOUT };

__device__ __forceinline__ void p0_transpose_block(const float* W, int K, int ldw, int nvalid, bf16_t* WT, int k0, int n0, int drow0, LAS unsigned* scr, int lane, const float* gk) {
    const int nq = lane & 15, kr = lane >> 4, nn = n0 + 4 * nq; const bool ok = nn < nvalid;
    const float* src = W + (size_t)(k0 + 2 * kr) * ldw + nn;
    f32x4 a[8], b[8];
#pragma unroll
    for (int j = 0; j < 8; ++j) { a[j] = ok ? __builtin_nontemporal_load((const GAS f32x4*)(src + (size_t)(8 * j) * ldw)) : (f32x4){0.f, 0.f, 0.f, 0.f}; b[j] = ok ? __builtin_nontemporal_load((const GAS f32x4*)(src + (size_t)(8 * j + 1) * ldw)) : (f32x4){0.f, 0.f, 0.f, 0.f}; }
    if (gk) {
#pragma unroll
        for (int j = 0; j < 8; ++j) { const f32x2 gg = *(const GAS f32x2*)(gk + k0 + 8 * j + 2 * kr); a[j] = a[j] * gg[0]; b[j] = b[j] * gg[1]; }
    }
#pragma unroll
    for (int j = 0; j < 8; ++j)
#pragma unroll
        for (int e = 0; e < 4; ++e) scr[(4 * nq + e) * 36 + 4 * j + kr] = pk2(a[j][e], b[j][e]);
    LDS_WAIT(); asm volatile("" ::: "memory");
#pragma unroll
    for (int i = 0; i < 8; ++i) { const int id = lane + 64 * i, n = id >> 3, c = id & 7;
        const u32x4 v = *(const LAS u32x4*)(scr + n * 36 + 4 * c);
        __builtin_nontemporal_store(v, (GAS u32x4*)(WT + (size_t)(drow0 + n) * K + k0 + 8 * c)); }
    LDS_WAIT(); asm volatile("" ::: "memory");
}
__device__ __forceinline__ void p0_transpose_block_f8(const float* W, int K, int ldw, unsigned char* WT8, int k0, int n0, int drow0, LAS unsigned* scr, int lane, const float* gk) {
    const int nq = lane & 15, kr = lane >> 4;
    const float* src = W + (size_t)(k0 + 4 * kr) * ldw + n0 + 4 * nq;
    f32x4 v[4][4];
#pragma unroll
    for (int j = 0; j < 4; ++j)
#pragma unroll
        for (int r = 0; r < 4; ++r) v[j][r] = __builtin_nontemporal_load((const GAS f32x4*)(src + (size_t)(16 * j + r) * ldw));
    if (gk) {
#pragma unroll
        for (int j = 0; j < 4; ++j) { const f32x4 gg = *(const GAS f32x4*)(gk + k0 + 16 * j + 4 * kr);
#pragma unroll
            for (int r = 0; r < 4; ++r) v[j][r] = v[j][r] * gg[r]; }
    }
#pragma unroll
    for (int j = 0; j < 4; ++j)
#pragma unroll
        for (int e = 0; e < 4; ++e) { int w = 0;
            const float x0 = fminf(fmaxf(v[j][0][e] * 64.0f, -448.0f), 448.0f), x1 = fminf(fmaxf(v[j][1][e] * 64.0f, -448.0f), 448.0f);
            const float x2 = fminf(fmaxf(v[j][2][e] * 64.0f, -448.0f), 448.0f), x3 = fminf(fmaxf(v[j][3][e] * 64.0f, -448.0f), 448.0f);
            w = __builtin_amdgcn_cvt_pk_fp8_f32(x0, x1, w, false); w = __builtin_amdgcn_cvt_pk_fp8_f32(x2, x3, w, true);
            scr[(4 * nq + e) * 20 + 4 * j + kr] = (unsigned)w; }
    LDS_WAIT(); asm volatile("" ::: "memory");
#pragma unroll
    for (int i = 0; i < 4; ++i) { const int id = lane + 64 * i, n = id >> 2, c = id & 3;
        const u32x4 x = *(const LAS u32x4*)(scr + n * 20 + 4 * c);
        __builtin_nontemporal_store(x, (GAS u32x4*)(WT8 + (size_t)(drow0 + n) * K + k0 + 16 * c)); }
    LDS_WAIT(); asm volatile("" ::: "memory");
}
__device__ __forceinline__ void p0_matrix_item_f8(const float* W, int K, int N, unsigned char* WT8, int mode, int r, LAS unsigned* scr, int lane, const float* gk) {
    const int nblk = N / 64, kb = r / nblk, nb = r % nblk, k0 = 64 * kb, n0 = 64 * nb;
    int drow0 = n0;
    if (mode == 1) drow0 = (n0 >> 7) * 256 + (n0 & 127);
    else if (mode == 2) drow0 = (n0 >> 7) * 256 + 128 + (n0 & 127);
    p0_transpose_block_f8(W, K, N, WT8, k0, n0, drow0, scr, lane, gk);
}
__device__ __forceinline__ void p0_matrix_item(const float* W, int K, int N, int Np, bf16_t* WT, int mode, int r, LAS unsigned* scr, int lane, const float* gk) {
    const int nblk = Np / 64, kb = r / nblk, nb = r % nblk, k0 = 64 * kb, n0 = 64 * nb;
    int drow0 = n0;
    if (mode == 1) drow0 = (n0 >> 7) * 256 + (n0 & 127);
    else if (mode == 2) drow0 = (n0 >> 7) * 256 + 128 + (n0 & 127);
    else if (mode == 3) { if (n0 >= 4096) { const int n2 = n0 - 4096; drow0 = 2048 + (n2 >> 7) * 256 + 128 + (n2 & 127); } else if (n0 >= 2048) { const int n1 = n0 - 2048; drow0 = 2048 + (n1 >> 7) * 256 + (n1 & 127); } }
    p0_transpose_block(W, K, N, N, WT, k0, n0, drow0, scr, lane, gk);
}
__device__ __forceinline__ void p0_prologue(Ctx& F) {
    unsigned char* const ws_ = F_WS(F);
    LAS unsigned* scr = (LAS unsigned*)(F.lds + F.wave * 16384);
    const int lane = F.lane;
    unsigned char* ws = ws_;
    const float* const NGp = inp(F, I_NG);
#define GN(L_, i_) (NGp + ((size_t)(L_) * 8 + (i_)) * D)
    constexpr int IT_FF = 2816, IT_PG = 1024, IT_PP = 128, IT_LAYER = 6 * IT_FF + IT_PG + IT_PP;
    constexpr int IT_NIN = 32 * (NSA_NP / 64), IT_NOUT = 1024, IT_W1 = 64 * 4, IT_W2 = 4 * 2, IT_NSA = IT_NIN + IT_NOUT + 2 * IT_W1 + 2 * IT_W2;
    constexpr int IT_CIN = 32 * 96, IT_COUT = 1024, IT_SIN = 32 * 64, IT_SOUT = 1024;
    constexpr int T0 = DEPTH * IT_LAYER, T1 = T0 + 2 * IT_NSA, T2 = T1 + IT_CIN + IT_COUT, T3 = T2 + IT_SIN + IT_SOUT;
    for (int it = F_GW(F); it < T3; it += F_NGW(F)) {
        if (it < T0) {
            const int L = it / IT_LAYER; int r = it % IT_LAYER; unsigned char* lw = ws + WS_LW + (size_t)L * LW_SIZE;
            if (r < 6 * IT_FF) { const int mi = r / IT_FF; r %= IT_FF;
                const size_t woff = (size_t)L * D * FF;
                const int hsw = 2 * L + (mi >= 3 ? 1 : 0);
                const bool f8 = ((mi == 2 || mi == 5) ? D_F8(hsw) : GU_F8(hsw)) != 0u;
                if (f8) {
                    if (mi == 0) p0_matrix_item_f8(inp(F, I_F1G) + woff, D, FF, lw + LW_GU1, 1, r, scr, lane, GN(L, 0));
                    else if (mi == 1) p0_matrix_item_f8(inp(F, I_F1U) + woff, D, FF, lw + LW_GU1, 2, r, scr, lane, GN(L, 0));
                    else if (mi == 2) p0_matrix_item_f8(inp(F, I_F1D) + woff, FF, D, lw + LW_D1, 0, r, scr, lane, nullptr);
                    else if (mi == 3) p0_matrix_item_f8(inp(F, I_F2G) + woff, D, FF, lw + LW_GU2, 1, r, scr, lane, GN(L, 4));
                    else if (mi == 4) p0_matrix_item_f8(inp(F, I_F2U) + woff, D, FF, lw + LW_GU2, 2, r, scr, lane, GN(L, 4));
                    else p0_matrix_item_f8(inp(F, I_F2D) + woff, FF, D, lw + LW_D2, 0, r, scr, lane, nullptr);
                } else {
                    if (mi == 0) p0_matrix_item(inp(F, I_F1G) + woff, D, FF, FF, (bf16_t*)(lw + LW_GU1), 1, r, scr, lane, GN(L, 0));
                    else if (mi == 1) p0_matrix_item(inp(F, I_F1U) + woff, D, FF, FF, (bf16_t*)(lw + LW_GU1), 2, r, scr, lane, GN(L, 0));
                    else if (mi == 2) p0_matrix_item(inp(F, I_F1D) + woff, FF, D, D, (bf16_t*)(lw + LW_D1), 0, r, scr, lane, nullptr);
                    else if (mi == 3) p0_matrix_item(inp(F, I_F2G) + woff, D, FF, FF, (bf16_t*)(lw + LW_GU2), 1, r, scr, lane, GN(L, 4));
                    else if (mi == 4) p0_matrix_item(inp(F, I_F2U) + woff, D, FF, FF, (bf16_t*)(lw + LW_GU2), 2, r, scr, lane, GN(L, 4));
                    else p0_matrix_item(inp(F, I_F2D) + woff, FF, D, D, (bf16_t*)(lw + LW_D2), 0, r, scr, lane, nullptr);
                }
            } else { r -= 6 * IT_FF;
                if (r < IT_PG) p0_matrix_item(inp(F, I_PLG) + (size_t)L * D * D, D, D, D, (bf16_t*)(lw + LW_PG), 0, r, scr, lane, GN(L, 6));
                else p0_matrix_item(inp(F, I_PLP) + (size_t)L * PLE * D, PLE, D, D, (bf16_t*)(lw + LW_PP), 0, r - IT_PG, scr, lane, nullptr);
            }
        } else if (it < T1) {
            const int j = (it - T0) / IT_NSA; int r = (it - T0) % IT_NSA; unsigned char* nw = ws + WS_NSA + (size_t)j * NW_SIZE;
            if (r < IT_NIN) { const int nblk = NSA_NP / 64, kb = r / nblk, nb = r % nblk;
                p0_transpose_block(inp(F, I_NIN) + (size_t)j * D * NSA_N, D, NSA_N, NSA_N, (bf16_t*)(nw + NW_IN), 64 * kb, 64 * nb, 64 * nb, scr, lane, GN(3 * j, 2)); }
            else if ((r -= IT_NIN) < IT_NOUT) p0_matrix_item(inp(F, I_NOUT) + (size_t)j * D * D, D, D, D, (bf16_t*)(nw + NW_OUT), 0, r, scr, lane, nullptr);
            else if ((r -= IT_NOUT) < 2 * IT_W1) { const int kv = r / IT_W1; r %= IT_W1;
                p0_matrix_item(inp(F, I_PW1) + (size_t)(j * 2 + kv) * 4096 * 256, 4096, 256, 256, (bf16_t*)(nw + NW_W1) + (size_t)kv * 256 * 4096, 0, r, scr, lane, nullptr); }
            else { r -= 2 * IT_W1; const int kv = r / IT_W2; r %= IT_W2;
                p0_matrix_item(inp(F, I_PW2) + (size_t)(j * 2 + kv) * 256 * 128, 256, 128, 128, (bf16_t*)(nw + NW_W2) + (size_t)kv * 128 * 256, 0, r, scr, lane, nullptr); }
        } else if (it < T2) {
            int r = it - T1;
            if (r < IT_CIN) p0_matrix_item(inp(F, I_CIN), D, 3 * D, 3 * D, (bf16_t*)(ws + WS_CV_IN), 3, r, scr, lane, GN(1, 2));
            else p0_matrix_item(inp(F, I_COUT), D, D, D, (bf16_t*)(ws + WS_CV_OUT), 0, r - IT_CIN, scr, lane, nullptr);
        } else {
            int r = it - T2;
            if (r < IT_SIN) p0_matrix_item(inp(F, I_SIN), D, 2 * D, 2 * D, (bf16_t*)(ws + WS_SG_IN), 0, r, scr, lane, GN(2, 2));
            else p0_matrix_item(inp(F, I_SOUT), D, D, D, (bf16_t*)(ws + WS_SG_OUT), 0, r - IT_SIN, scr, lane, nullptr);
        }
    }
#undef GN
    {
        const size_t n8 = (size_t)DEPTH * M * PLE / 8; const float* p = inp(F, I_P); bf16_t* pb = (bf16_t*)(ws + WS_PB);
        for (size_t i = (size_t)F_GW(F) * 64 + lane; i < n8; i += (size_t)F_NGW(F) * 64) {
            const f32x4 a = *(const GAS f32x4*)(p + i * 8), b = *(const GAS f32x4*)(p + i * 8 + 4);
            u32x4 o; o.x = pk2(a[0], a[1]); o.y = pk2(a[2], a[3]); o.z = pk2(b[0], b[1]); o.w = pk2(b[2], b[3]);
            *(GAS u32x4*)(pb + i * 8) = o; }
    }
    {
        float* tab = (float*)(ws + WS_ROPE);
        for (int i = F_GW(F) * 64 + lane; i < SEQ * 16; i += F_NGW(F) * 64) { const int pos = i >> 4, fi = i & 15;
            const float inv = powf(500000.0f, -(float)fi / 16.0f); const float ang = (float)pos * inv;
            tab[2 * i] = (float)cos((double)ang); tab[2 * i + 1] = (float)sin((double)ang); }
    }
    {
        const float* wsp = inp(F, I_SWS); bf16_t* o = (bf16_t*)(ws + WS_SG_WS);
        for (int i = F_GW(F) * 64 + lane; i < 8 * 128 * 128; i += F_NGW(F) * 64) { const int t = (i >> 7) & 127, s = i & 127; o[i] = (bf16_t)f2bf(s <= t ? wsp[i] : 0.f); }
    }
    {
        for (int it = F_GW(F); it < 2 * 2 * 16 * 4; it += F_NGW(F)) { const int nc = it & 3, sl = (it >> 2) & 15, kv = (it >> 6) & 1, j = it >> 7;
            const float* pe = inp(F, I_PE) + (size_t)(j * 2 + kv) * 4096; const float* w1 = inp(F, I_PW1) + (size_t)(j * 2 + kv) * 4096 * 256;
            const int n = nc * 64 + lane; float s = 0.f;
            for (int k0 = sl * 256; k0 < sl * 256 + 256; k0 += 16) {
                float wv[16], pv[16];
#pragma unroll
                for (int u = 0; u < 16; ++u) { wv[u] = w1[(size_t)(k0 + u) * 256 + n]; pv[u] = pe[k0 + u]; }
#pragma unroll
                for (int u = 0; u < 16; ++u) s += pv[u] * wv[u];
            }
            ((float*)(ws + WS_NSA + (size_t)j * NW_SIZE + NW_BP))[(kv * 16 + sl) * 256 + n] = s; }
    }
}

__device__ __forceinline__ void norm_phase(Ctx& F, const bf16_t* m, const bf16_t* hin, const float* x32, float alpha, const float* gpost, bf16_t* h, float* rstd, float* fout, unsigned char* hq8 = nullptr) {
    const int lane = F.lane;
    f32x4 gp[4][2];
    if (m) {
#pragma unroll
        for (int j = 0; j < 4; ++j) { gp[j][0] = *(const GAS f32x4*)(gpost + 8 * lane + 512 * j); gp[j][1] = *(const GAS f32x4*)(gpost + 8 * lane + 512 * j + 4); }
    }
    for (int row = F_GW(F); row < M; row += F_NGW(F)) {
        const size_t ro = (size_t)row * D;
        float hv[4][8];
        if (m) {
            float v[4][8]; float ss = 0.f;
#pragma unroll
            for (int j = 0; j < 4; ++j) { const u32x4 w = *(const GAS u32x4*)(m + ro + 8 * lane + 512 * j), hw = *(const GAS u32x4*)(hin + ro + 8 * lane + 512 * j);
                const unsigned ww[4] = {w.x, w.y, w.z, w.w}, hh[4] = {hw.x, hw.y, hw.z, hw.w};
#pragma unroll
                for (int e = 0; e < 4; ++e) { v[j][2 * e] = bf_lo(ww[e]); v[j][2 * e + 1] = bf_hi(ww[e]); hv[j][2 * e] = bf_lo(hh[e]); hv[j][2 * e + 1] = bf_hi(hh[e]);
                    ss += v[j][2 * e] * v[j][2 * e] + v[j][2 * e + 1] * v[j][2 * e + 1]; } }
            const float r = alpha * rsqrtf(wave_sum(ss) * (1.0f / D) + EPS);
#pragma unroll
            for (int j = 0; j < 4; ++j) {
#pragma unroll
                for (int e = 0; e < 4; ++e) { hv[j][e] += v[j][e] * r * gp[j][0][e]; hv[j][4 + e] += v[j][4 + e] * r * gp[j][1][e]; } }
        } else {
#pragma unroll
            for (int j = 0; j < 4; ++j) { const f32x4 a = *(const GAS f32x4*)(x32 + ro + 8 * lane + 512 * j), b = *(const GAS f32x4*)(x32 + ro + 8 * lane + 512 * j + 4);
#pragma unroll
                for (int e = 0; e < 4; ++e) { hv[j][e] = a[e]; hv[j][4 + e] = b[e]; } }
        }
        if (fout) {
#pragma unroll
            for (int j = 0; j < 4; ++j) { *(GAS f32x4*)(fout + ro + 8 * lane + 512 * j) = (f32x4){hv[j][0], hv[j][1], hv[j][2], hv[j][3]}; *(GAS f32x4*)(fout + ro + 8 * lane + 512 * j + 4) = (f32x4){hv[j][4], hv[j][5], hv[j][6], hv[j][7]}; }
        } else {
#pragma unroll
            for (int j = 0; j < 4; ++j) { u32x4 o; o.x = pk2(hv[j][0], hv[j][1]); o.y = pk2(hv[j][2], hv[j][3]); o.z = pk2(hv[j][4], hv[j][5]); o.w = pk2(hv[j][6], hv[j][7]);
                *(GAS u32x4*)(h + ro + 8 * lane + 512 * j) = o;
                if (hq8) {
                    float c[8];
#pragma unroll
                    for (int e = 0; e < 8; ++e) c[e] = fminf(fmaxf(hv[j][e] * 8.0f, -448.0f), 448.0f);
                    int w0 = 0, w1 = 0;
                    w0 = __builtin_amdgcn_cvt_pk_fp8_f32(c[0], c[1], w0, false); w0 = __builtin_amdgcn_cvt_pk_fp8_f32(c[2], c[3], w0, true);
                    w1 = __builtin_amdgcn_cvt_pk_fp8_f32(c[4], c[5], w1, false); w1 = __builtin_amdgcn_cvt_pk_fp8_f32(c[6], c[7], w1, true);
                    u32x2 w; w.x = (unsigned)w0; w.y = (unsigned)w1; *(GAS u32x2*)(hq8 + ro + 8 * lane + 512 * j) = w; } }
        }
        if (rstd) {
            float ss = 0.f;
#pragma unroll
            for (int j = 0; j < 4; ++j)
#pragma unroll
                for (int e = 0; e < 8; ++e) ss += hv[j][e] * hv[j][e];
            const float st = wave_sum(ss);
            if (lane == 0) { float z = 0.f; asm volatile("" : "+v"(z));
                *(GAS f32x4*)(rstd + (size_t)row * 8) = (f32x4){st, z, z, z}; *(GAS f32x4*)(rstd + (size_t)row * 8 + 4) = (f32x4){z, z, z, z}; }
        }
    }
}

__device__ __forceinline__ void nsa_prep_phase(Ctx& F) {
    unsigned char* const ws_ = F_WS(F);
    const bf16_t* proj = (const bf16_t*)(ws_ + WS_PROJ); const float* tab = (const float*)(ws_ + WS_ROPE);
    const int lane = F.lane, sub = lane & 15, grp = lane >> 4;
    const int NITEM = M * 8;
    for (int it = (F_GW(F) * 4 + grp); it < NITEM; it += F_NGW(F) * 4) {
        const int row = it >> 3, slot = 16 + (it & 7), b = row >> 12, s = row & 4095;
        const bf16_t* src; bf16_t* dst;
        if (slot < 16) { src = proj + (size_t)row * NSA_NP + OFF_Q + slot * 128; dst = (bf16_t*)(ws_ + WS_QR) + (size_t)row * D + slot * 128; }
        else if (slot < 20) { const int g = slot - 16; src = proj + (size_t)row * NSA_NP + OFF_KS + g * 128; dst = (bf16_t*)(ws_ + WS_KSR) + ((size_t)(b * 4 + g) * SEQ + s) * 128; }
        else { const int g = slot - 20; src = proj + (size_t)row * NSA_NP + OFF_KW + g * 128; dst = (bf16_t*)(ws_ + WS_KWR) + ((size_t)(b * 4 + g) * SEQ + s) * 128; }
        if (sub >= 4) { *(GAS u32x4*)(dst + sub * 8) = *(const GAS u32x4*)(src + sub * 8); }
        else if (sub < 2) {
            const u32x4 a = *(const GAS u32x4*)(src + sub * 8), c = *(const GAS u32x4*)(src + 16 + sub * 8);
            const float* tb = tab + ((size_t)s * 16 + sub * 8) * 2;
            u32x4 o1, o2; unsigned aw[4] = {a.x, a.y, a.z, a.w}, cw[4] = {c.x, c.y, c.z, c.w}, r1[4], r2[4];
#pragma unroll
            for (int e = 0; e < 4; ++e) {
                const f32x4 cs = *(const GAS f32x4*)(tb + 4 * e);
                const float x1a = bf_lo(aw[e]), x1b = bf_hi(aw[e]), x2a = bf_lo(cw[e]), x2b = bf_hi(cw[e]);
                r1[e] = pk2(x1a * cs[0] - x2a * cs[1], x1b * cs[2] - x2b * cs[3]);
                r2[e] = pk2(x2a * cs[0] + x1a * cs[1], x2b * cs[2] + x1b * cs[3]);
            }
            o1.x = r1[0]; o1.y = r1[1]; o1.z = r1[2]; o1.w = r1[3]; o2.x = r2[0]; o2.y = r2[1]; o2.z = r2[2]; o2.w = r2[3];
            *(GAS u32x4*)(dst + sub * 8) = o1; *(GAS u32x4*)(dst + 16 + sub * 8) = o2;
        }
    }
    LAS bf16_t* scr = (LAS bf16_t*)(F.lds + F.wave * 9216);
    for (int it = F_GW(F); it < 2 * 8 * 64 * 2; it += F_NGW(F)) {
        const int dh = it & 1, st = (it >> 1) & 63, bg = (it >> 7) & 7, which = it >> 10, b = bg >> 2, g = bg & 3, s0 = st * 64;
        const bf16_t* src = proj + (size_t)(b * SEQ + s0) * NSA_NP + (which ? OFF_VW : OFF_VS) + g * 128 + dh * 64;
        bf16_t* dst = (bf16_t*)(ws_ + (which ? WS_VWT : WS_VST)) + ((size_t)bg * 128 + dh * 64) * SEQ + s0;
#pragma unroll 4
        for (int i = 0; i < 8; ++i) { const int s = 8 * i + (lane >> 3), c = lane & 7;
            const u32x4 v = *(const GAS u32x4*)(src + (size_t)s * NSA_NP + c * 8); const unsigned w[4] = {v.x, v.y, v.z, v.w};
#pragma unroll
            for (int e = 0; e < 4; ++e) { scr[(8 * c + 2 * e) * 72 + s] = (bf16_t)(w[e] & 0xffffu); scr[(8 * c + 2 * e + 1) * 72 + s] = (bf16_t)(w[e] >> 16); } }
        LDS_WAIT(); asm volatile("" ::: "memory");
#pragma unroll 4
        for (int i = 0; i < 8; ++i) { const int id = lane + 64 * i, d = id >> 3, sc = id & 7;
            const u32x4 v = *(const LAS u32x4*)(scr + d * 72 + sc * 8);
            *(GAS u32x4*)(dst + (size_t)d * SEQ + sc * 8) = v; }
        LDS_WAIT(); asm volatile("" ::: "memory");
    }
}

__device__ __forceinline__ void nsa_cmp_hidden_phase(Ctx& F, int j) {
    unsigned char* const ws_ = F_WS(F);
    const bf16_t* proj = (const bf16_t*)(ws_ + WS_PROJ);
    const unsigned char* nw = ws_ + WS_NSA + (size_t)j * NW_SIZE;
    const int tid = F.tid, lane = F.lane, wave = F.wave, fr = lane & 15, fq = lane >> 4, wr = wave >> 2, wc = wave & 3;
    constexpr int ACS = 1040, AIMG = 16 * ACS;
    LAS unsigned char* lA = F.lds, * lB = F.lds + 2 * AIMG;
    const int srow = ((tid >> 6) & 3) * 16 + (tid & 15), scol = (tid >> 8) * 4 + ((tid >> 4) & 3);
    for (int u = F.wg; u < 256; u += F.G) {
        const int nt4 = u & 3, ct4 = (u >> 2) & 3, bg = (u >> 4) & 7, kv = u >> 7, b = bg >> 2, g = bg & 3, c0 = ct4 * 64, n0 = nt4 * 64;
        const bf16_t* abase = proj + (size_t)(b * SEQ) * NSA_NP + (kv ? OFF_VC : OFF_KC) + g * 128;
        const bf16_t* aSrc = abase + (size_t)(16 * (c0 + srow)) * NSA_NP + scol * 8;
        const bf16_t* aX = abase + (size_t)(16 * (c0 + 64) + (tid >> 4)) * NSA_NP + (tid & 15) * 8;
        const bf16_t* bSrc = (const bf16_t*)(nw + NW_W1) + (size_t)kv * 256 * 4096 + (size_t)(n0 + srow) * 4096 + scol * 8;
        f32x4 acc[2] = {{0.f, 0.f, 0.f, 0.f}, {0.f, 0.f, 0.f, 0.f}};
        u32x4 pa[2][2][2], pb[2][4][2], px[2] = {{0u, 0u, 0u, 0u}, {0u, 0u, 0u, 0u}};
#define CMP_LOAD(set_, i_) do { \
            _Pragma("unroll") for (int q = 0; q < 2; ++q) { const bf16_t* a2 = aSrc + (size_t)((i_) + q) * NSA_NP; pa[set_][q][0] = *(const GAS u32x4*)(a2); pa[set_][q][1] = *(const GAS u32x4*)(a2 + 64); } \
            if (tid < 32) px[set_] = *(const GAS u32x4*)(aX + (size_t)(i_) * NSA_NP); \
            _Pragma("unroll") for (int q = 0; q < 4; ++q) { const bf16_t* b2 = bSrc + ((i_) + (q & 1) + 16 * (q >> 1)) * 128; pb[set_][q][0] = *(const GAS u32x4*)(b2); pb[set_][q][1] = *(const GAS u32x4*)(b2 + 64); } } while (0)
#define CMP_STEP(set_, i_) do { \
            __syncthreads(); \
            _Pragma("unroll") for (int q = 0; q < 2; ++q) { *(LAS u32x4*)(lA + q * AIMG + scol * ACS + srow * 16) = pa[set_][q][0]; *(LAS u32x4*)(lA + q * AIMG + (scol + 8) * ACS + srow * 16) = pa[set_][q][1]; } \
            if (tid < 32) *(LAS u32x4*)(lA + (tid >> 4) * AIMG + (tid & 15) * ACS + 64 * 16) = px[set_]; \
            _Pragma("unroll") for (int q = 0; q < 4; ++q) { *(LAS u32x4*)(lB + q * 16384 + scol * 1024 + srow * 16) = pb[set_][q][0]; *(LAS u32x4*)(lB + q * 16384 + (scol + 8) * 1024 + srow * 16) = pb[set_][q][1]; } \
            __syncthreads(); \
            if ((i_) + 4 < 16) CMP_LOAD(set_, (i_) + 4); \
            _Pragma("unroll") for (int q = 0; q < 4; ++q)                \
            _Pragma("unroll") for (int ks = 0; ks < 4; ++ks) { \
                const bf16x8 bf = *(const LAS bf16x8*)(lB + q * 16384 + (ks * 4 + fq) * 1024 + (wc * 16 + fr) * 16); \
                _Pragma("unroll") for (int mt = 0; mt < 2; ++mt) { const bf16x8 af = *(const LAS bf16x8*)(lA + (q & 1) * AIMG + (ks * 4 + fq) * ACS + (wr * 32 + mt * 16 + fr + (q >> 1)) * 16); \
                    acc[mt] = __builtin_amdgcn_mfma_f32_16x16x32_bf16(bf, af, acc[mt], 0, 0, 0); } } } while (0)
        CMP_LOAD(0, 0); CMP_LOAD(1, 2);
        for (int i = 0; i < 16; i += 4) { CMP_STEP(0, i); CMP_STEP(1, i + 2); }
#undef CMP_LOAD
#undef CMP_STEP
        const float* b1p = inp(F, I_PB1) + (size_t)(j * 2 + kv) * 256; const float* bp = (const float*)(nw + NW_BP) + (size_t)kv * 16 * 256;
        const int nn = n0 + wc * 16 + 4 * fq; float bias[4];
#pragma unroll
        for (int e = 0; e < 4; ++e) { bias[e] = b1p[nn + e];
#pragma unroll
            for (int sl = 0; sl < 16; ++sl) bias[e] += bp[sl * 256 + nn + e]; }
#pragma unroll
        for (int mt = 0; mt < 2; ++mt) { const int c = c0 + wr * 32 + mt * 16 + fr; float o[4];
#pragma unroll
            for (int e = 0; e < 4; ++e) { o[e] = pg8::silu_f(acc[mt][e] + bias[e]); if (c == 255) o[e] = 0.f; }
            u32x2 w; w.x = pk2(o[0], o[1]); w.y = pk2(o[2], o[3]);
            *(GAS u32x2*)((bf16_t*)(ws_ + WS_HID) + ((size_t)(kv * 8 + bg) * 256 + c) * 256 + nn) = w; }
    }
    __syncthreads();
}
__device__ __forceinline__ void nsa_cmp_out_phase(Ctx& F, int j) {
    unsigned char* const ws_ = F_WS(F);
    const unsigned char* nw = ws_ + WS_NSA + (size_t)j * NW_SIZE;
    const int lane = F.lane, fr = lane & 15, fq = lane >> 4;
    for (int it = F_GW(F); it < 2 * 8 * 16 * 2; it += F_NGW(F)) {
        const int dq = it & 1, ct = (it >> 1) & 15, bg = (it >> 5) & 7, kv = it >> 8;
        const bf16_t* hid = (const bf16_t*)(ws_ + WS_HID) + ((size_t)(kv * 8 + bg) * 256 + ct * 16 + fr) * 256 + 8 * fq;
        const bf16_t* w2t = (const bf16_t*)(nw + NW_W2) + (size_t)kv * 128 * 256 + (size_t)(dq * 64 + fr) * 256 + 8 * fq;
        f32x4 acc[4];
#pragma unroll
        for (int nt = 0; nt < 4; ++nt) acc[nt] = (f32x4){0.f, 0.f, 0.f, 0.f};
#pragma unroll
        for (int ks = 0; ks < 8; ++ks) {
            const bf16x8 af = *(const GAS bf16x8*)(hid + ks * 32);
#pragma unroll
            for (int nt = 0; nt < 4; ++nt) { const bf16x8 bf = *(const GAS bf16x8*)(w2t + (size_t)nt * 16 * 256 + ks * 32);
                if (kv == 0) acc[nt] = __builtin_amdgcn_mfma_f32_16x16x32_bf16(bf, af, acc[nt], 0, 0, 0);
                else acc[nt] = __builtin_amdgcn_mfma_f32_16x16x32_bf16(af, bf, acc[nt], 0, 0, 0);
            }
        }
        if (kv == 0) { bf16_t* kc = (bf16_t*)(ws_ + WS_KC) + ((size_t)bg * 256 + ct * 16 + fr) * 128 + dq * 64 + 4 * fq;
#pragma unroll
            for (int nt = 0; nt < 4; ++nt) { u32x2 w; w.x = pk2(acc[nt][0], acc[nt][1]); w.y = pk2(acc[nt][2], acc[nt][3]); *(GAS u32x2*)(kc + nt * 16) = w; }
        } else { bf16_t* vct = (bf16_t*)(ws_ + WS_VCT) + ((size_t)bg * 128 + dq * 64 + fr) * 256 + ct * 16 + 4 * fq;
#pragma unroll
            for (int nt = 0; nt < 4; ++nt) { u32x2 w; w.x = pk2(acc[nt][0], acc[nt][1]); w.y = pk2(acc[nt][2], acc[nt][3]); *(GAS u32x2*)(vct + (size_t)nt * 16 * 256) = w; }
        }
    }
}

namespace att {
constexpr int VP = 144;
constexpr int L_K = 0, L_V = 16384, L_Q = 34816, L_IMP = 100352, L_MASK = 116736;
constexpr float CS = 0.08838834764831845f * 1.4426950408889634f;

__device__ __forceinline__ int launder(int v) { asm volatile("" : "+v"(v)); return v; }
__device__ __forceinline__ float red4_max(float x) {
    auto r = __builtin_amdgcn_permlane16_swap(__float_as_uint(x), __float_as_uint(x), false, false); x = fmaxf(__uint_as_float(r[0]), __uint_as_float(r[1]));
    auto q = __builtin_amdgcn_permlane32_swap(__float_as_uint(x), __float_as_uint(x), false, false); return fmaxf(__uint_as_float(q[0]), __uint_as_float(q[1]));
}
__device__ __forceinline__ float max3(float a, float b, float c) { float r; asm("v_max3_f32 %0, %1, %2, %3" : "=v"(r) : "v"(a), "v"(b), "v"(c)); return r; }
__device__ __forceinline__ float red4_sum(float x) {
    auto r = __builtin_amdgcn_permlane16_swap(__float_as_uint(x), __float_as_uint(x), false, false); x = __uint_as_float(r[0]) + __uint_as_float(r[1]);
    auto q = __builtin_amdgcn_permlane32_swap(__float_as_uint(x), __float_as_uint(x), false, false); return __uint_as_float(q[0]) + __uint_as_float(q[1]);
}
struct Tile { u32x4 k0, k1, v0, v1; };
__device__ __forceinline__ void tile_load(Tile& T, const bf16_t* Kb, const bf16_t* VTb, int vpitch, int key0, int tid) {
    const int c0 = tid, c1 = tid + 512;
    const int key = ((tid >> 6) & 3) * 16 + (tid & 15), col = (tid >> 8) * 4 + ((tid >> 4) & 3);
    T.k0 = *(const GAS u32x4*)(Kb + (size_t)(key0 + key) * 128 + col * 8);
    T.k1 = *(const GAS u32x4*)(Kb + (size_t)(key0 + key) * 128 + (col + 8) * 8);
    T.v0 = *(const GAS u32x4*)(VTb + (size_t)(c0 >> 3) * vpitch + key0 + (c0 & 7) * 8);
    T.v1 = *(const GAS u32x4*)(VTb + (size_t)(c1 >> 3) * vpitch + key0 + (c1 & 7) * 8);
}
__device__ __forceinline__ void tile_store(const Tile& T, LAS unsigned char* lds, int tid) {
    const int c0 = tid, c1 = tid + 512;
    const int key = ((tid >> 6) & 3) * 16 + (tid & 15), col = (tid >> 8) * 4 + ((tid >> 4) & 3);
    *(LAS u32x4*)(lds + L_K + col * 1024 + key * 16) = T.k0;
    *(LAS u32x4*)(lds + L_K + (col + 8) * 1024 + key * 16) = T.k1;
    *(LAS u32x4*)(lds + L_V + (c0 >> 3) * VP + (c0 & 7) * 16) = T.v0;
    *(LAS u32x4*)(lds + L_V + (c1 >> 3) * VP + (c1 & 7) * 16) = T.v1;
}
template <int MODE>
__device__ __forceinline__ void pass(LAS unsigned char* lds, const bf16_t* Kb, const bf16_t* VTb, int vpitch, int kt_lo, int kt_hi, int t0w  ,
                                     f32x4 (&ot)[8][2], float (&mrow)[2], float (&lrow)[2], const unsigned (&mlo)[2], const unsigned (&mhi)[2], int tid_, int wave,
                                     Tile& T, const bf16_t* nKb, const bf16_t* nVTb, int nvp, int nkey0) {
    const int tid = launder(tid_), lane = tid & 63, fr = lane & 15, fq = lane >> 4;
    LAS unsigned char* qb = lds + L_Q + wave * 8192 + fq * 512 + fr * 16;
    LAS unsigned char* kb = lds + L_K + fq * 1024 + fr * 16;
    LAS unsigned char* vb = lds + L_V + fr * VP + fq * 8;
    LAS float* imp = (LAS float*)(lds + L_IMP);
    float bcarry[2] = {0.f, 0.f};
    for (int kt = kt_lo; kt <= kt_hi; ++kt) {
        __syncthreads();
        tile_store(T, lds, tid);
        __syncthreads();
        if (kt < kt_hi) tile_load(T, Kb, VTb, vpitch, (kt + 1) * 64, tid);
        else if (nKb) tile_load(T, nKb, nVTb, nvp, nkey0, tid);
        f32x4 st[4][2];
        {
            bf16x8 qc0 = *(const LAS bf16x8*)(qb), qc1 = *(const LAS bf16x8*)(qb + 256), kc[4];
#pragma unroll
            for (int kk = 0; kk < 4; ++kk) kc[kk] = *(const LAS bf16x8*)(kb + kk * 256);
#pragma unroll
            for (int ks = 0; ks < 4; ++ks) {
                bf16x8 qn0 = qc0, qn1 = qc1, kn[4] = {kc[0], kc[1], kc[2], kc[3]};
                if (ks < 3) { qn0 = *(const LAS bf16x8*)(qb + (ks + 1) * 2048); qn1 = *(const LAS bf16x8*)(qb + (ks + 1) * 2048 + 256);
#pragma unroll
                    for (int kk = 0; kk < 4; ++kk) kn[kk] = *(const LAS bf16x8*)(kb + (ks + 1) * 4096 + kk * 256); }
                __builtin_amdgcn_sched_barrier(0);
#pragma unroll
                for (int kk = 0; kk < 4; ++kk) {
                    st[kk][0] = __builtin_amdgcn_mfma_f32_16x16x32_bf16(kc[kk], qc0, ks ? st[kk][0] : (f32x4){0.f, 0.f, 0.f, 0.f}, 0, 0, 0);
                    st[kk][1] = __builtin_amdgcn_mfma_f32_16x16x32_bf16(kc[kk], qc1, ks ? st[kk][1] : (f32x4){0.f, 0.f, 0.f, 0.f}, 0, 0, 0); }
                __builtin_amdgcn_sched_barrier(0);
                qc0 = qn0; qc1 = qn1;
#pragma unroll
                for (int kk = 0; kk < 4; ++kk) kc[kk] = kn[kk];
            }
        }
        asm volatile("s_nop 7" : "+v"(st[0][0]), "+v"(st[0][1]), "+v"(st[1][0]), "+v"(st[1][1]), "+v"(st[2][0]), "+v"(st[2][1]), "+v"(st[3][0]), "+v"(st[3][1]));
        bool emask;
        if (MODE <= 1) emask = (kt * 1024 + 1039 > t0w);
        else if (MODE == 2) emask = (kt == kt_hi);
        else emask = (kt == kt_hi) || (kt == kt_lo && kt_hi - kt_lo == 8);
        bf16x8 pf[2][2];
#pragma unroll
        for (int qt = 0; qt < 2; ++qt) {
            const int t = t0w + 4 * qt + (fr >> 2);
            float sv[4][4];
            float rowbias = 0.f;
            if (MODE == 2) { const bool sel_ok = (kt < 32) ? ((mlo[qt] >> kt) & 1u) : ((mhi[qt] >> (kt - 32)) & 1u); rowbias = sel_ok ? 0.f : -INFINITY; }
            if (emask) {
#pragma unroll
                for (int kk = 0; kk < 4; ++kk)
#pragma unroll
                    for (int e = 0; e < 4; ++e) {
                        const int key = kt * 64 + kk * 16 + fq * 4 + e; bool ok;
                        if (MODE <= 1) ok = (16 * key + 31 <= t);
                        else if (MODE == 2) ok = (key <= t);
                        else ok = (key <= t) && (t - key < 512);
                        sv[kk][e] = ok ? st[kk][qt][e] : -INFINITY;
                    }
            } else {
#pragma unroll
                for (int kk = 0; kk < 4; ++kk)
#pragma unroll
                    for (int e = 0; e < 4; ++e) sv[kk][e] = st[kk][qt][e];
            }
            if (MODE != 1) {
                float mx = max3(max3(sv[0][0], sv[0][1], sv[0][2]), max3(sv[0][3], sv[1][0], sv[1][1]), max3(sv[1][2], sv[1][3], sv[2][0]));
                mx = max3(mx, max3(sv[2][1], sv[2][2], sv[2][3]), max3(sv[3][0], sv[3][1], max3(sv[3][2], sv[3][3], sv[3][3])));
                mx = red4_max(mx);
                const float mxs = mx * CS + rowbias;
                float alpha = 1.f;
                if (__any(mxs > mrow[qt] + 6.0f)) {
                    const float mnew = fmaxf(mrow[qt], mxs);
                    alpha = __builtin_amdgcn_exp2f(mrow[qt] - mnew);
                    mrow[qt] = mnew;
                    if (MODE != 0) {
#pragma unroll
                        for (int dt = 0; dt < 8; ++dt) ot[dt][qt] = ot[dt][qt] * alpha;
                    }
                }
                const float boff = rowbias - mrow[qt];
                float psum = 0.f;
#pragma unroll
                for (int kk = 0; kk < 4; ++kk)
#pragma unroll
                    for (int e = 0; e < 4; ++e) { const float p = __builtin_amdgcn_exp2f(fmaf(sv[kk][e], CS, boff)); sv[kk][e] = p; psum += p; }
                psum = red4_sum(psum);
                lrow[qt] = lrow[qt] * alpha + psum;
            } else {
                const float boff = -mrow[qt], rinv = lrow[qt];
#pragma unroll
                for (int kk = 0; kk < 4; ++kk) {
#pragma unroll
                    for (int e = 0; e < 4; ++e) sv[kk][e] = __builtin_amdgcn_exp2f(fmaf(sv[kk][e], CS, boff)) * rinv;
                    float a = 2.f * ((sv[kk][0] + sv[kk][1]) + sv[kk][2]) + sv[kk][3], bq = sv[kk][3];
                    a += __shfl_xor(a, 1); a += __shfl_xor(a, 2); bq += __shfl_xor(bq, 1); bq += __shfl_xor(bq, 2);
                    const float bl = __shfl(bq, (lane + 48) & 63);
                    const float bc = __shfl(bcarry[qt], (lane + 48) & 63);
                    const float bprev = fq > 0 ? bl : bc;
                    bcarry[qt] = bq;
                    if ((fr & 3) == 0) imp[((wave * 8 + 4 * qt + (fr >> 2)) << 6) + ((kt * 16 + kk * 4 + fq) & 63)] = a + bprev;
                }
            }
            if (MODE != 0) {
#pragma unroll
                for (int kp = 0; kp < 2; ++kp) {
                    u32x4 w; w.x = pg8::cvt_pk_bf16(sv[2 * kp][0], sv[2 * kp][1]); w.y = pg8::cvt_pk_bf16(sv[2 * kp][2], sv[2 * kp][3]);
                    w.z = pg8::cvt_pk_bf16(sv[2 * kp + 1][0], sv[2 * kp + 1][1]); w.w = pg8::cvt_pk_bf16(sv[2 * kp + 1][2], sv[2 * kp + 1][3]);
                    pf[kp][qt] = __builtin_bit_cast(bf16x8, w);
                }
            }
        }
        if (MODE != 0) {
            u32x2 va[4], vc[4];
#pragma unroll
            for (int i = 0; i < 4; ++i) { va[i] = *(const LAS u32x2*)(vb + i * 16 * VP); vc[i] = *(const LAS u32x2*)(vb + i * 16 * VP + 32); }
#pragma unroll
            for (int grp = 0; grp < 4; ++grp) {
                const int kp = grp >> 1, d0 = (grp & 1) * 4;
                u32x2 na[4] = {va[0], va[1], va[2], va[3]}, nc[4] = {vc[0], vc[1], vc[2], vc[3]};
                if (grp < 3) { const int kp2 = (grp + 1) >> 1, e0 = ((grp + 1) & 1) * 4;
#pragma unroll
                    for (int i = 0; i < 4; ++i) { na[i] = *(const LAS u32x2*)(vb + (e0 + i) * 16 * VP + kp2 * 64); nc[i] = *(const LAS u32x2*)(vb + (e0 + i) * 16 * VP + kp2 * 64 + 32); } }
                __builtin_amdgcn_sched_barrier(0);
#pragma unroll
                for (int i = 0; i < 4; ++i) { u32x4 vw; vw.x = va[i].x; vw.y = va[i].y; vw.z = vc[i].x; vw.w = vc[i].y; const bf16x8 vf = __builtin_bit_cast(bf16x8, vw);
                    ot[d0 + i][0] = __builtin_amdgcn_mfma_f32_16x16x32_bf16(vf, pf[kp][0], ot[d0 + i][0], 0, 0, 0);
                    ot[d0 + i][1] = __builtin_amdgcn_mfma_f32_16x16x32_bf16(vf, pf[kp][1], ot[d0 + i][1], 0, 0, 0); }
                __builtin_amdgcn_sched_barrier(0);
#pragma unroll
                for (int i = 0; i < 4; ++i) { va[i] = na[i]; vc[i] = nc[i]; }
            }
        }
    }
}
__device__ __forceinline__ void load_q(LAS unsigned char* lds, const bf16_t* src  , int pitch, int wave, int lane, const float* tab = nullptr, int pos0 = 0) {
#pragma unroll
    for (int i = 0; i < 8; ++i) { const int c = lane + 64 * i, rr = c >> 4, ch = c & 15;
        const bf16_t* rp = src + (size_t)(rr >> 2) * pitch + (rr & 3) * 128;
        u32x4 v = *(const GAS u32x4*)(rp + ch * 8);
        if (tab && ch < 4) {
            const u32x4 pw = *(const GAS u32x4*)(rp + (ch ^ 2) * 8);
            const float* tb = tab + ((size_t)(pos0 + (rr >> 2)) * 16 + (ch & 1) * 8) * 2;
            const unsigned ow[4] = {v.x, v.y, v.z, v.w}, qw[4] = {pw.x, pw.y, pw.z, pw.w}; unsigned r[4];
#pragma unroll
            for (int e = 0; e < 4; ++e) {
                const f32x4 cs = *(const GAS f32x4*)(tb + 4 * e);
                const float oa = bf_lo(ow[e]), ob = bf_hi(ow[e]), pa = bf_lo(qw[e]), pb = bf_hi(qw[e]);
                r[e] = (ch < 2) ? pk2(oa * cs[0] - pa * cs[1], ob * cs[2] - pb * cs[3])
                                : pk2(oa * cs[0] + pa * cs[1], ob * cs[2] + pb * cs[3]);
            }
            v.x = r[0]; v.y = r[1]; v.z = r[2]; v.w = r[3];
        }
        *(LAS u32x4*)(lds + L_Q + wave * 8192 + ch * 512 + rr * 16) = v; }
}
__device__ __forceinline__ void unit(Ctx& F, int bg, int qb, Tile& T, bool chain) {
    unsigned char* const ws_ = F_WS(F);
    LAS unsigned char* lds = F.lds;
    const int tid = launder(F.tid), wave = F.wave; int lane = tid & 63, fr = lane & 15, fq = lane >> 4;
    const int b = bg >> 2, g = bg & 3, t0w = qb * 64 + wave * 8;
    const bf16_t* proj = (const bf16_t*)(ws_ + WS_PROJ);
    const bf16_t* prow = proj + (size_t)(b * SEQ + t0w) * NSA_NP;
    f32x4 ot[8][2];
    float* MBf = (float*)(ws_ + WS_MB);
    float mrow[2], lrow[2]; unsigned mlo[2] = {0u, 0u}, mhi[2] = {0u, 0u};
    const bf16_t* KCb = (const bf16_t*)(ws_ + WS_KC) + (size_t)bg * 256 * 128; const bf16_t* VCb = (const bf16_t*)(ws_ + WS_VCT) + (size_t)bg * 128 * 256;
    const bf16_t* KSb = (const bf16_t*)(ws_ + WS_KSR) + (size_t)bg * SEQ * 128; const bf16_t* VSb = (const bf16_t*)(ws_ + WS_VST) + (size_t)bg * 128 * SEQ;
    const bf16_t* KWb = (const bf16_t*)(ws_ + WS_KWR) + (size_t)bg * SEQ * 128; const bf16_t* VWb = (const bf16_t*)(ws_ + WS_VWT) + (size_t)bg * 128 * SEQ;
    const int klo = qb >= 8 ? qb - 8 : 0;
    float gate[3][2];
#pragma unroll
    for (int qt = 0; qt < 2; ++qt)
#pragma unroll
        for (int br = 0; br < 3; ++br) { const bf16_t gv = prow[(size_t)(4 * qt + (fr >> 2)) * NSA_NP + OFF_GATE + br * 16 + 4 * g + (fr & 3)];
            gate[br][qt] = pg8::fast_sigmoid(__uint_as_float((unsigned)gv << 16)); }
    __syncthreads();
    load_q(lds, prow + OFF_Q + g * 512, NSA_NP, wave, lane);
    const int nct = (4 * qb + 2) / 64;
    mrow[0] = mrow[1] = -1e30f; lrow[0] = lrow[1] = 0.f;
    pass<0>(lds, KCb, VCb, 256, 0, nct, t0w, ot, mrow, lrow, mlo, mhi, tid, wave, T, KCb, VCb, 256, 0);
#pragma unroll
    for (int qt = 0; qt < 2; ++qt) lrow[qt] = 1.0f / fmaxf(lrow[qt], 1e-30f);
#pragma unroll
    for (int dt = 0; dt < 8; ++dt) { ot[dt][0] = (f32x4){0.f, 0.f, 0.f, 0.f}; ot[dt][1] = (f32x4){0.f, 0.f, 0.f, 0.f}; }
    pass<1>(lds, KCb, VCb, 256, 0, nct, t0w, ot, mrow, lrow, mlo, mhi, tid, wave, T, KSb, VSb, SEQ, 0);
    lane = launder(tid) & 63; fr = lane & 15; fq = lane >> 4;
#pragma unroll
    for (int qt = 0; qt < 2; ++qt) { float* mrowp = MBf + (size_t)(b * SEQ + t0w + 4 * qt + (fr >> 2)) * D + (4 * g + (fr & 3)) * 128 + 4 * fq;
#pragma unroll
        for (int dt = 0; dt < 8; ++dt) *(GAS f32x4*)(mrowp + dt * 16) = ot[dt][qt] * gate[0][qt]; }
    {
        LAS float* imp = (LAS float*)(lds + L_IMP); LAS unsigned* msk = (LAS unsigned*)(lds + L_MASK);
        lane = launder(tid) & 63; fr = lane & 15; fq = lane >> 4;
        LDS_WAIT();
        if (qb <= 15) {
            const unsigned long long mm = (1ull << (qb + 1)) - 1ull;
            mlo[0] = mlo[1] = (unsigned)mm; mhi[0] = mhi[1] = (unsigned)(mm >> 32);
        } else {
            const int jhi = qb - 2;
#pragma nounroll
            for (int i = 0; i < 8; ++i) {
                const int tl = wave * 8 + i;
                const float v = imp[(tl << 6) + lane];
                int cnt = 0;
                for (int j2 = 1; j2 <= jhi; ++j2) { const float v2 = imp[(tl << 6) + j2]; cnt += (v2 > v || (v2 == v && j2 < lane)) ? 1 : 0; }
                const bool sel = (lane >= 1) && (lane <= jhi) && (cnt < 13);
                const unsigned long long bal = __ballot(sel) | 1ull | (1ull << qb) | (1ull << (qb - 1));
                if (lane == 0) { msk[2 * tl] = (unsigned)bal; msk[2 * tl + 1] = (unsigned)(bal >> 32); }
            }
            LDS_WAIT();
#pragma unroll
            for (int qt = 0; qt < 2; ++qt) { const int tl = wave * 8 + 4 * qt + (fr >> 2); mlo[qt] = msk[2 * tl]; mhi[qt] = msk[2 * tl + 1]; }
        }
    }
    lane = launder(tid) & 63; fr = lane & 15; fq = lane >> 4;
    load_q(lds, prow + OFF_Q + g * 512, NSA_NP, wave, lane, (const float*)(ws_ + WS_ROPE), t0w);
    {
        mrow[0] = mrow[1] = -1e30f; lrow[0] = lrow[1] = 0.f;
#pragma unroll
        for (int dt = 0; dt < 8; ++dt) { ot[dt][0] = (f32x4){0.f, 0.f, 0.f, 0.f}; ot[dt][1] = (f32x4){0.f, 0.f, 0.f, 0.f}; }
        pass<2>(lds, KSb, VSb, SEQ, 0, qb, t0w, ot, mrow, lrow, mlo, mhi, tid, wave, T, KWb, VWb, SEQ, klo * 64);
        lane = launder(tid) & 63; fr = lane & 15; fq = lane >> 4;
#pragma unroll
        for (int qt = 0; qt < 2; ++qt) { const float sc = gate[1][qt] / fmaxf(lrow[qt], 1e-30f);
            float* mrowp = MBf + (size_t)(b * SEQ + t0w + 4 * qt + (fr >> 2)) * D + (4 * g + (fr & 3)) * 128 + 4 * fq;
#pragma unroll
            for (int dt = 0; dt < 8; ++dt) { const f32x4 o = *(const GAS f32x4*)(mrowp + dt * 16); *(GAS f32x4*)(mrowp + dt * 16) = o + ot[dt][qt] * sc; } }
    }
    {
        mrow[0] = mrow[1] = -1e30f; lrow[0] = lrow[1] = 0.f;
#pragma unroll
        for (int dt = 0; dt < 8; ++dt) { ot[dt][0] = (f32x4){0.f, 0.f, 0.f, 0.f}; ot[dt][1] = (f32x4){0.f, 0.f, 0.f, 0.f}; }
        pass<3>(lds, KWb, VWb, SEQ, klo, qb, t0w, ot, mrow, lrow, mlo, mhi, tid, wave, T, chain ? KCb : nullptr, VCb, 256, 0);
        bf16_t* O = (bf16_t*)(ws_ + WS_O);
        lane = launder(tid) & 63; fr = lane & 15; fq = lane >> 4;
#pragma unroll
        for (int qt = 0; qt < 2; ++qt) { const float sc = gate[2][qt] / fmaxf(lrow[qt], 1e-30f);
            const size_t ro = (size_t)(b * SEQ + t0w + 4 * qt + (fr >> 2)) * D + (4 * g + (fr & 3)) * 128 + 4 * fq;
#pragma unroll
            for (int dt = 0; dt < 8; ++dt) { const f32x4 o = *(const GAS f32x4*)(MBf + ro + dt * 16) + ot[dt][qt] * sc;
                u32x2 w; w.x = pk2(o[0], o[1]); w.y = pk2(o[2], o[3]); *(GAS u32x2*)(O + ro + dt * 16) = w; } }
    }
}
__device__ __forceinline__ void phase(Ctx& F) {
    if (F.wave >= 4) __builtin_amdgcn_s_setprio(1);
    for (int u2 = 2 * F.wg; u2 < 512; u2 += 2 * F.G) {
        const int u = u2 >> 1, bg = u >> 5, x = u & 31;
        Tile T; { unsigned char* const ws_ = F_WS(F); tile_load(T, (const bf16_t*)(ws_ + WS_KC) + (size_t)bg * 256 * 128, (const bf16_t*)(ws_ + WS_VCT) + (size_t)bg * 128 * 256, 256, 0, launder(F.tid)); }
#pragma nounroll
        for (int k2 = 0; k2 < 2; ++k2) unit(F, bg, k2 ? 63 - x : x, T, k2 == 0); }
    __builtin_amdgcn_s_setprio(0);
    __syncthreads();
}
}

__device__ __forceinline__ void conv_phase(Ctx& F) {
    unsigned char* const ws_ = F_WS(F);
    const bf16_t* BG = (const bf16_t*)(ws_ + WS_PROJ); const bf16_t* Z = BG + (size_t)M * D; bf16_t* O = (bf16_t*)(ws_ + WS_O);
    const float* cw = inp(F, I_CW);
    const size_t n8 = (size_t)M * D / 8;
    for (size_t i = (size_t)F_GW(F) * 64 + F.lane; i < n8; i += (size_t)F_NGW(F) * 64) {
        const int row = (int)(i >> 8), c8 = (int)(i & 255) * 8, s = row & 4095;
        const u32x4 bgv = *(const GAS u32x4*)(BG + (size_t)row * D + c8), z0 = *(const GAS u32x4*)(Z + (size_t)row * D + c8);
        u32x4 z1 = {0u, 0u, 0u, 0u}, z2 = {0u, 0u, 0u, 0u};
        if (s >= 1) z1 = *(const GAS u32x4*)(Z + (size_t)(row - 1) * D + c8);
        if (s >= 2) z2 = *(const GAS u32x4*)(Z + (size_t)(row - 2) * D + c8);
        const unsigned bw[4] = {bgv.x, bgv.y, bgv.z, bgv.w}, a0[4] = {z0.x, z0.y, z0.z, z0.w}, a1[4] = {z1.x, z1.y, z1.z, z1.w}, a2[4] = {z2.x, z2.y, z2.z, z2.w};
        unsigned o[4];
#pragma unroll
        for (int e = 0; e < 4; ++e) {
            const int c = c8 + 2 * e;
            const float lo = bf_lo(bw[e]) * (cw[c] * bf_lo(a2[e]) + cw[D + c] * bf_lo(a1[e]) + cw[2 * D + c] * bf_lo(a0[e]));
            const float hi = bf_hi(bw[e]) * (cw[c + 1] * bf_hi(a2[e]) + cw[D + c + 1] * bf_hi(a1[e]) + cw[2 * D + c + 1] * bf_hi(a0[e]));
            o[e] = pk2(lo, hi);
        }
        u32x4 ov; ov.x = o[0]; ov.y = o[1]; ov.z = o[2]; ov.w = o[3];
        *(GAS u32x4*)(O + (size_t)row * D + c8) = ov;
    }
}

__device__ __forceinline__ void sgu_ln_phase(Ctx& F) {
    unsigned char* const ws_ = F_WS(F);
    const bf16_t* Z2 = (const bf16_t*)(ws_ + WS_PROJ); bf16_t* VLN = (bf16_t*)(ws_ + WS_QR);
    const float* lg = inp(F, I_SLG); const float* lb = inp(F, I_SLB); const int lane = F.lane;
    for (int row = F_GW(F); row < M; row += F_NGW(F)) {
        float v[32]; float s = 0.f;
#pragma unroll
        for (int j = 0; j < 4; ++j) { const u32x4 w = *(const GAS u32x4*)(Z2 + (size_t)row * 4096 + 2048 + 8 * lane + 512 * j); const unsigned ww[4] = {w.x, w.y, w.z, w.w};
#pragma unroll
            for (int e = 0; e < 4; ++e) { v[8 * j + 2 * e] = bf_lo(ww[e]); v[8 * j + 2 * e + 1] = bf_hi(ww[e]); s += v[8 * j + 2 * e] + v[8 * j + 2 * e + 1]; } }
        const float mean = wave_sum(s) * (1.0f / 2048.0f); float q = 0.f;
#pragma unroll
        for (int e = 0; e < 32; ++e) { v[e] -= mean; q += v[e] * v[e]; }
        const float rstd = rsqrtf(wave_sum(q) * (1.0f / 2048.0f) + EPS);
#pragma unroll
        for (int j = 0; j < 4; ++j) { const int c0 = 8 * lane + 512 * j; unsigned o[4];
            const f32x4 g0 = *(const GAS f32x4*)(lg + c0), g1 = *(const GAS f32x4*)(lg + c0 + 4), b0 = *(const GAS f32x4*)(lb + c0), b1 = *(const GAS f32x4*)(lb + c0 + 4);
            o[0] = pk2(v[8 * j + 0] * rstd * g0[0] + b0[0], v[8 * j + 1] * rstd * g0[1] + b0[1]); o[1] = pk2(v[8 * j + 2] * rstd * g0[2] + b0[2], v[8 * j + 3] * rstd * g0[3] + b0[3]);
            o[2] = pk2(v[8 * j + 4] * rstd * g1[0] + b1[0], v[8 * j + 5] * rstd * g1[1] + b1[1]); o[3] = pk2(v[8 * j + 6] * rstd * g1[2] + b1[2], v[8 * j + 7] * rstd * g1[3] + b1[3]);
            u32x4 ov; ov.x = o[0]; ov.y = o[1]; ov.z = o[2]; ov.w = o[3];
            *(GAS u32x4*)(VLN + (size_t)row * D + c0) = ov; }
    }
}
__device__ __forceinline__ void sgu_spatial_phase(Ctx& F) {
    unsigned char* const ws_ = F_WS(F);
    const bf16_t* Z2 = (const bf16_t*)(ws_ + WS_PROJ); const bf16_t* VLN = (const bf16_t*)(ws_ + WS_QR); bf16_t* O = (bf16_t*)(ws_ + WS_O);
    const bf16_t* WSB = (const bf16_t*)(ws_ + WS_SG_WS); const float* bs = inp(F, I_SBS);
    const int tid = F.tid, lane = F.lane, wave = F.wave, fr = lane & 15, fq = lane >> 4;
    LAS bf16_t* vt = (LAS bf16_t*)F.lds;
    for (int u = F.wg; u < 64 * 8; u += F.G) {
        const int g = u & 7, c = u >> 3, row0 = c * 128;
        __syncthreads();
#pragma unroll 2
        for (int i = 0; i < 8; ++i) { const int id = tid + 512 * i, s = id >> 5, cc = id & 31;
            const u32x4 v = *(const GAS u32x4*)(VLN + (size_t)(row0 + s) * D + g * 256 + cc * 8); const unsigned w[4] = {v.x, v.y, v.z, v.w};
#pragma unroll
            for (int e = 0; e < 4; ++e) { vt[(8 * cc + 2 * e) * 136 + s] = (bf16_t)(w[e] & 0xffffu); vt[(8 * cc + 2 * e + 1) * 136 + s] = (bf16_t)(w[e] >> 16); } }
        __syncthreads();
        f32x4 acc[16];
#pragma unroll
        for (int nt = 0; nt < 16; ++nt) acc[nt] = (f32x4){0.f, 0.f, 0.f, 0.f};
#pragma unroll
        for (int ks = 0; ks < 4; ++ks) {
            const bf16x8 af = *(const GAS bf16x8*)(WSB + ((size_t)g * 128 + wave * 16 + fr) * 128 + ks * 32 + 8 * fq);
#pragma unroll
            for (int nt = 0; nt < 16; ++nt) { const bf16x8 bf = *(const LAS bf16x8*)(vt + (nt * 16 + fr) * 136 + ks * 32 + 8 * fq);
                acc[nt] = __builtin_amdgcn_mfma_f32_16x16x32_bf16(bf, af, acc[nt], 0, 0, 0); }
        }
        const int t = wave * 16 + fr; const float bias = bs[g * 128 + t];
        const bf16_t* urow = Z2 + (size_t)(row0 + t) * 4096 + g * 256 + 4 * fq; bf16_t* orow = O + (size_t)(row0 + t) * D + g * 256 + 4 * fq;
#pragma unroll
        for (int nt = 0; nt < 16; ++nt) { const u32x2 uv = *(const GAS u32x2*)(urow + nt * 16);
            u32x2 w; w.x = pk2(bf_lo(uv.x) * (acc[nt][0] + bias), bf_hi(uv.x) * (acc[nt][1] + bias)); w.y = pk2(bf_lo(uv.y) * (acc[nt][2] + bias), bf_hi(uv.y) * (acc[nt][3] + bias));
            *(GAS u32x2*)(orow + nt * 16) = w; }
    }
    __syncthreads();
}

struct Args { const float* in[26]; float* out; unsigned char* ws; int ph_lo, ph_hi; };
constexpr int N_PHASES = 2 + 11 + 8 + 9 + 11;

__global__ void __launch_bounds__(512, 2) mk_fwd(Args args) {
    extern __shared__ __attribute__((aligned(16))) unsigned char lds_raw[];
    Ctx F;
    F.lds = (LAS unsigned char*)lds_raw;
    const int wave0 = __builtin_amdgcn_readfirstlane((int)threadIdx.x >> 6);
    F.lane = (int)__builtin_amdgcn_mbcnt_hi(~0u, __builtin_amdgcn_mbcnt_lo(~0u, 0u)); F.wave = wave0; F.tid = wave0 * 64 + F.lane;
    F.G = gridDim.x; F.wg = blockIdx.x;
    volatile LAS unsigned* MISC = (volatile LAS unsigned*)(F.lds + MISC_OFF);
    for (int u = F.tid; u < (LDS_BYTES - LDSCTL_OFF) / 4; u += 512) ((LAS unsigned*)(F.lds + LDSCTL_OFF))[u] = 0u;
    __syncthreads();
    if (F.tid == 0) {
#pragma unroll
        for (int i = 0; i < 26; ++i) *(LAS unsigned long long*)(F.lds + PTR_OFF + 8 * i) = (unsigned long long)args.in[i];
        *(LAS unsigned long long*)(F.lds + PTR_OFF + 8 * 26) = (unsigned long long)args.out;
        *(LAS unsigned long long*)(F.lds + PTR_OFF + 8 * 27) = (unsigned long long)args.ws;
    }
    __syncthreads();
    const int lo = args.ph_lo, hi = args.ph_hi;
    if (hi - lo > 1) { XcdBarrier b0 = xcd_barrier_post((unsigned*)(args.ws + WS_CTL) + CW_BAR, MISC + 8); if (F.tid == 0) MISC[10] = b0.x; }
    __syncthreads();
    int ph = 0;
#define GRID_BAR() do { XcdBarrier b_; b_.bar = (unsigned*)(F_WS(F) + WS_CTL) + CW_BAR; b_.x = (unsigned)__builtin_amdgcn_readfirstlane((int)MISC[10]); b_.st = MISC + 8; xcd_barrier(b_); } while (0)
#define PH_BEGIN(b) if (EN(b) && ph >= lo && ph < hi) { { unsigned m_ = ~0u; asm volatile("" : "+s"(m_)); int l_ = (int)__builtin_amdgcn_mbcnt_hi(m_, __builtin_amdgcn_mbcnt_lo(m_, 0u)); asm volatile("" : "+v"(l_)); F.lane = l_; F.wave = wave0; F.tid = wave0 * 64 + l_; int g_ = (int)gridDim.x, w_ = (int)blockIdx.x; asm volatile("" : "+s"(g_), "+s"(w_)); F.G = g_; F.wg = w_; } unsigned char* const ws_ = F_WS(F); (void)ws_; {
#define PH_END   } if (ph + 1 < hi) GRID_BAR(); } ++ph;
#define P_RS   ((float*)(ws_ + WS_HN))
#define P_SSM  ((float*)(ws_ + WS_HN + MiB))
#define P_CTLW ((unsigned*)(ws_ + WS_CTL))
#define RSL_SETUP(S_) LAS float* rsl = (LAS float*)(F.lds + EPI_RED_OFF); int pm0 = -1; { pg8::Unit u0_; if ((S_).next(0, u0_)) { pm0 = u0_.pm; if (F.tid < 256) rsl[F.tid] = pg8::row_rs(P_RS, pm0 * 256 + F.tid); } } __syncthreads();
#define EPI_NORM(fz_, g_, alpha_, hq8_) pg8::EpiNorm<false>{P_HB, (g_), (alpha_), P_SSM, P_RS, P_CTLW + CW_NORM + (fz_) * 512, P_CTLW + CW_BAR, nullptr, (hq8_), (LAS float*)(F.lds + EPI_RED_OFF), F.tid, nullptr, nullptr}
#define P_ACT  ((bf16_t*)(ws_ + WS_ACT))
#define P_MB   ((bf16_t*)(ws_ + WS_MB))
#define P_HB   ((bf16_t*)(ws_ + WS_HB))
#define P_OB   ((bf16_t*)(ws_ + WS_O))
#define P_PROJ ((bf16_t*)(ws_ + WS_PROJ))
#define P_GATE ((bf16_t*)(ws_ + WS_GATE))
#define P_HQ8  ((unsigned char*)(ws_ + WS_GATE))
#define P_LW   (ws_ + WS_LW + (size_t)L * LW_SIZE)
#define P_G    (inp(F, I_NG) + (size_t)L * 8 * D)

    PH_BEGIN(0)
        p0_prologue(F);
        norm_phase(F, nullptr, nullptr, inp(F, I_X), 0.f, nullptr, P_HB, P_RS, nullptr, GU_F8(0) ? P_HQ8 : nullptr);
    PH_END
    PH_BEGIN(15)
        for (int L = 0; L < DEPTH; ++L) {
            pg8::Gemm gm{(const bf16_t*)(ws_ + WS_PB) + (size_t)L * M * PLE, (const bf16_t*)(P_LW + LW_PP), M, D, PLE}; pg8::StaticOrder S; S.init(M, D, F.G, F.wg);
            pg8::EpiBf16<0> E{(bf16_t*)(ws_ + WS_PE) + (size_t)L * M * D, D, nullptr};
            pg8::gemm_phase<pg8::EpiBf16<0>, pg8::StaticOrder, true, true>(F.lds, gm, S, E, F.tid);
        }
    PH_END

    for (int hs = 0; hs < 2 * DEPTH; ++hs) {
        const int L = hs >> 1, second = hs & 1;
        {
            const bool gu8 = GU_F8(hs) != 0u, d8 = D_F8(hs) != 0u;
            PH_BEGIN(1)
                pg8::Gemm gm{gu8 ? (const bf16_t*)P_HQ8 : (const bf16_t*)P_HB, (const bf16_t*)(P_LW + (second ? LW_GU2 : LW_GU1)), M, 2 * FF, D}; pg8::StaticOrder S; S.init(M, 2 * FF, F.G, F.wg);
                RSL_SETUP(S)
                if (gu8) {
                    if (d8) { if constexpr (ffn_combo_used(1, 1)) { pg8::EpiSwiglu<true> E{(void*)P_ACT, FF, P_RS, rsl, pm0}; pg8::gemm_phase<pg8::EpiSwiglu<true>, pg8::StaticOrder, true, true, true>(F.lds, gm, S, E, F.tid); } }
                    else { if constexpr (ffn_combo_used(1, 0)) { pg8::EpiSwiglu<false> E{(void*)P_ACT, FF, P_RS, rsl, pm0}; pg8::gemm_phase<pg8::EpiSwiglu<false>, pg8::StaticOrder, true, true, true>(F.lds, gm, S, E, F.tid); } }
                } else {
                    if (d8) { if constexpr (ffn_combo_used(0, 1)) { pg8::EpiSwiglu<true> E{(void*)P_ACT, FF, P_RS, rsl, pm0}; pg8::gemm_phase<pg8::EpiSwiglu<true>, pg8::StaticOrder, true, true, false>(F.lds, gm, S, E, F.tid); } }
                    else { if constexpr (ffn_combo_used(0, 0)) { pg8::EpiSwiglu<false> E{(void*)P_ACT, FF, P_RS, rsl, pm0}; pg8::gemm_phase<pg8::EpiSwiglu<false>, pg8::StaticOrder, true, true, false>(F.lds, gm, S, E, F.tid); } }
                }
            PH_END
            PH_BEGIN(1)
                pg8::Gemm gm{P_ACT, (const bf16_t*)(P_LW + (second ? LW_D2 : LW_D1)), M, D, FF}; pg8::StaticOrder S; S.init(M, D, F.G, F.wg);
                const pg8::EpiNorm<false> E = EPI_NORM(2 * hs, P_G + (second ? 5 : 1) * D, 0.5f, nullptr);
                if (d8) { if constexpr (ffn_d_used(1)) pg8::gemm_phase<pg8::EpiNorm<false>, pg8::StaticOrder, true, true, true>(F.lds, gm, S, E, F.tid); }
                else { if constexpr (ffn_d_used(0)) pg8::gemm_phase<pg8::EpiNorm<false>, pg8::StaticOrder, true, true, false>(F.lds, gm, S, E, F.tid); }
            PH_END
        }
        if (!second) {
            const int kind = L % 3, j = L / 3;
            if (kind == 0) {
                PH_BEGIN(3)
                    pg8::Gemm gm{P_HB, (const bf16_t*)(ws_ + WS_NSA + (size_t)j * NW_SIZE + NW_IN), M, NSA_NP, D}; pg8::StaticOrder S; S.init(M, NSA_NP, F.G, F.wg);
                    RSL_SETUP(S)
                    pg8::EpiBf16<0> E{P_PROJ, NSA_NP, P_RS, rsl, pm0};
                    pg8::gemm_phase<pg8::EpiBf16<0>, pg8::StaticOrder, true, true>(F.lds, gm, S, E, F.tid);
                PH_END
                PH_BEGIN(4) nsa_prep_phase(F); PH_END
                PH_BEGIN(5) nsa_cmp_hidden_phase(F, j); PH_END
                PH_BEGIN(6) nsa_cmp_out_phase(F, j); PH_END
                PH_BEGIN(7) att::phase(F); PH_END
            } else if (kind == 1) {
                PH_BEGIN(8)
                    pg8::Gemm gm{P_HB, (const bf16_t*)(ws_ + WS_CV_IN), M, 3 * D, D}; pg8::StaticOrder S; S.init(M, 3 * D, F.G, F.wg);
                    RSL_SETUP(S)
                    pg8::EpiConvIn E{P_PROJ, P_PROJ + (size_t)M * D, P_RS, rsl, pm0};
                    pg8::gemm_phase<pg8::EpiConvIn, pg8::StaticOrder, true, true>(F.lds, gm, S, E, F.tid);
                PH_END
                PH_BEGIN(9) conv_phase(F); PH_END
            } else {
                PH_BEGIN(10)
                    pg8::Gemm gm{P_HB, (const bf16_t*)(ws_ + WS_SG_IN), M, 2 * D, D}; pg8::StaticOrder S; S.init(M, 2 * D, F.G, F.wg);
                    RSL_SETUP(S)
                    pg8::EpiBf16<1> E{P_PROJ, 2 * D, P_RS, rsl, pm0};
                    pg8::gemm_phase<pg8::EpiBf16<1>, pg8::StaticOrder, true, true>(F.lds, gm, S, E, F.tid);
                PH_END
                PH_BEGIN(11) sgu_ln_phase(F); PH_END
                PH_BEGIN(12) sgu_spatial_phase(F); PH_END
            }
            PH_BEGIN(13)
                const bf16_t* wout = (const bf16_t*)(kind == 0 ? ws_ + WS_NSA + (size_t)j * NW_SIZE + NW_OUT : (kind == 1 ? ws_ + WS_CV_OUT : ws_ + WS_SG_OUT));
                pg8::Gemm gm{P_OB, wout, M, D, D}; pg8::StaticOrder S; S.init(M, D, F.G, F.wg);
                const pg8::EpiNorm<false> E = EPI_NORM(2 * hs + 1, P_G + 3 * D, 1.0f, GU_F8(hs + 1) ? P_HQ8 : nullptr);
                pg8::gemm_phase<pg8::EpiNorm<false>, pg8::StaticOrder, true, true>(F.lds, gm, S, E, F.tid);
            PH_END
        } else {
            PH_BEGIN(14)
                pg8::Gemm gm{P_HB, (const bf16_t*)(P_LW + LW_PG), M, D, D}; pg8::StaticOrder S; S.init(M, D, F.G, F.wg);
                const bool lastl = (L + 1 == DEPTH);
                const pg8::EpiNorm<true> E{P_HB, P_G + 7 * D, 1.0f, P_SSM, lastl ? nullptr : P_RS, P_CTLW + CW_NORM + (2 * hs + 1) * 512, P_CTLW + CW_BAR, lastl ? F_OUT(F) : nullptr,
                                           (!lastl && GU_F8(hs + 1)) ? P_HQ8 : nullptr, (LAS float*)(F.lds + EPI_RED_OFF), F.tid, (const bf16_t*)(ws_ + WS_PE) + (size_t)L * M * D, P_RS};
                pg8::gemm_phase<pg8::EpiNorm<true>, pg8::StaticOrder, true, true>(F.lds, gm, S, E, F.tid);
            PH_END
        }
    }
#undef PH_BEGIN
#undef PH_END
}

extern "C" void kernel_launch(void* const* d_in, const int* in_sizes, int n_in, void* d_out, int out_size, void* d_ws, size_t ws_size, hipStream_t stream) {
    static int grid = 0;
    if (grid == 0) {
        if (n_in != 26 || out_size != M * D || ws_size < WS_END) { fprintf(stderr, "kernel_launch: unexpected shapes (n_in %d out %d ws %zu)\n", n_in, out_size, ws_size); grid = -1; return; }
        int dev = 0, cus = 0, per_cu = 0;
        if (hipGetDevice(&dev) != hipSuccess || hipDeviceGetAttribute(&cus, hipDeviceAttributeMultiprocessorCount, dev) != hipSuccess) { grid = -1; return; }
        if (hipFuncSetAttribute((const void*)mk_fwd, hipFuncAttributeMaxDynamicSharedMemorySize, LDS_BYTES) != hipSuccess) { fprintf(stderr, "kernel_launch: hipFuncSetAttribute failed\n"); grid = -1; return; }
        if (hipOccupancyMaxActiveBlocksPerMultiprocessor(&per_cu, (const void*)mk_fwd, 512, LDS_BYTES) != hipSuccess || per_cu < 1) { fprintf(stderr, "kernel_launch: occupancy query reports %d\n", per_cu); }
        (void)hipGetLastError();
        if (cus < 256) { fprintf(stderr, "kernel_launch: the fused-norm epilogue needs >= 256 resident workgroups (device has %d CUs)\n", cus); grid = -1; return; }
        grid = cus;
    }
    if (grid < 0) return;
    if (hipMemsetAsync((char*)d_ws + WS_CTL, 0, CTL_ZERO_BYTES, stream) != hipSuccess) return;
    Args a{};
    for (int i = 0; i < 26; ++i) a.in[i] = (const float*)d_in[i];
    a.out = (float*)d_out; a.ws = (unsigned char*)d_ws;
#if MK_ONE_LAUNCH
    a.ph_lo = 0; a.ph_hi = N_PHASES;
    hipLaunchKernelGGL(mk_fwd, dim3(grid), dim3(512), LDS_BYTES, stream, a);
#else
    for (int p = 0; p < N_PHASES; ++p) { a.ph_lo = p; a.ph_hi = p + 1; hipLaunchKernelGGL(mk_fwd, dim3(grid), dim3(512), LDS_BYTES, stream, a); }
#endif
}
```
